# Optimizing an MI355X kernel written in HIP

```python
import jax
import jax.numpy as jnp
from jax import lax
import numpy as np

D_MODEL = 1024
BATCH = 1
SEQ = 16384
DEPTH = 4

GRID_W = 64
CTX_LEN = 256
HEAD_DIM = 64
BRANCH_WIDTH = 256
N_BRANCH = 4
A_HEADS = 4
A_KV_HEADS = 2
A_GROUP = A_HEADS // A_KV_HEADS
Q_BLOCK = 128
ROPE_THETA = 10000.0
B_HEADS = 4
B_KEY_DIM = 64
B_VAL_DIM = 64
B_CHUNK = 64
C_GROUPS = 4
C_GROUP_DIM = BRANCH_WIDTH // C_GROUPS
C_WINDOWS = (2, 4, 8, 16)
D_HEADS = 4
NA_WIN_R = 8
NA_WIN_C = 16
D_FF = 2816
N_MOD = 9
EPS = 1e-6
ATTN_SCALE = HEAD_DIM ** -0.5

IN_SPLITS = (
    A_HEADS * HEAD_DIM, A_KV_HEADS * HEAD_DIM, A_KV_HEADS * HEAD_DIM,
    B_HEADS * B_KEY_DIM, B_HEADS * B_KEY_DIM, B_HEADS * B_KEY_DIM, B_HEADS * B_VAL_DIM, B_HEADS * B_VAL_DIM,
    BRANCH_WIDTH,
    D_HEADS * HEAD_DIM, D_HEADS * HEAD_DIM, D_HEADS * HEAD_DIM,
    N_BRANCH * D_MODEL,
)
IN_WIDTH = sum(IN_SPLITS)

kernel_name = 'hybrid_prefix_dit_block'


def rmsnorm(x, g):
    xf = x.astype(jnp.float32)
    y = xf * lax.rsqrt(jnp.mean(xf * xf, axis=-1, keepdims=True) + EPS)
    return (y * g.astype(jnp.float32)).astype(x.dtype)


def modulate(x, shift, scale):
    return x * (1 + scale) + shift


def swiglu(z, wg, wu, wd):
    return (jax.nn.silu(z @ wg) * (z @ wu)) @ wd


def ffn_half(z, shift, scale, gate, norm, wg, wu, wd):
    return z + 0.5 * gate * swiglu(modulate(rmsnorm(z, norm), shift, scale), wg, wu, wd)


def rope_tables(n):
    t = jnp.arange(n, dtype=jnp.int32)
    half = HEAD_DIM // 2
    inv = 1.0 / (ROPE_THETA ** (jnp.arange(0, half, 2, dtype=jnp.float32) / half))
    ang_r = (t // GRID_W).astype(jnp.float32)[:, None] * inv
    ang_c = (t % GRID_W).astype(jnp.float32)[:, None] * inv
    tab = jnp.stack([jnp.cos(ang_r), jnp.sin(ang_r), jnp.cos(ang_c), jnp.sin(ang_c)])
    return tab[:, :, None, :]


def _rotate(x, cos, sin):
    x1, x2 = jnp.split(x, 2, axis=-1)
    return jnp.concatenate([x1 * cos - x2 * sin, x2 * cos + x1 * sin], axis=-1)


def apply_axial_rope(x, rope):
    half = HEAD_DIM // 2
    xf = x.astype(jnp.float32)
    out = jnp.concatenate([_rotate(xf[..., :half], rope[0], rope[1]),
                           _rotate(xf[..., half:], rope[2], rope[3])], axis=-1)
    return out.astype(x.dtype)


def dense_attend(q, k, v):
    s = jnp.einsum('bqhgd,bkhd->bhgqk', q, k).astype(jnp.float32) * ATTN_SCALE
    p = jax.nn.softmax(s, axis=-1).astype(v.dtype)
    return jnp.einsum('bhgqk,bkhd->bqhgd', p, v)


def gqa_mixer(q, k, v, qc, kc, vc, q_gain, k_gain, rope, with_ctx_out):
    b, t = q.shape[:2]

    def norm_heads(a, n, g):
        return rmsnorm(a.reshape(a.shape[0], a.shape[1], n, HEAD_DIM), g)

    ql = apply_axial_rope(norm_heads(q, A_HEADS, q_gain), rope)
    kl = apply_axial_rope(norm_heads(k, A_KV_HEADS, k_gain), rope)
    vl = v.reshape(b, t, A_KV_HEADS, HEAD_DIM)
    kcx = norm_heads(kc, A_KV_HEADS, k_gain)
    vcx = vc.reshape(b, vc.shape[1], A_KV_HEADS, HEAD_DIM)
    k_all = jnp.concatenate([kcx, kl], axis=1)
    v_all = jnp.concatenate([vcx, vl], axis=1)
    qb = ql.reshape(b, t // Q_BLOCK, Q_BLOCK, A_KV_HEADS, A_GROUP, HEAD_DIM)
    ob = lax.map(lambda blk: dense_attend(blk, k_all, v_all), jnp.moveaxis(qb, 1, 0))
    y = jnp.moveaxis(ob, 0, 1).reshape(b, t, BRANCH_WIDTH)
    if not with_ctx_out:
        return y, None
    qcx = norm_heads(qc, A_HEADS, q_gain).reshape(b, qc.shape[1], A_KV_HEADS, A_GROUP, HEAD_DIM)
    yc = dense_attend(qcx, kcx, vcx).reshape(b, qc.shape[1], BRANCH_WIDTH)
    return y, yc


def gla_chunk_scan(q, k, v, log_f, s0):
    b, t, h, _ = q.shape
    n = t // B_CHUNK

    def to_chunks(a):
        return a.reshape(b, n, B_CHUNK, h, a.shape[-1]).transpose(1, 0, 3, 2, 4)

    causal = jnp.tril(jnp.ones((B_CHUNK, B_CHUNK), dtype=bool))[:, :, None]

    def step(s, inp):
        qc, kc, vc, lc = inp
        cum = jnp.cumsum(lc, axis=2)
        diff = cum[:, :, :, None, :] - cum[:, :, None, :, :]
        decay = jnp.exp(jnp.where(causal, diff, -jnp.inf))
        att = jnp.einsum('bhtd,bhsd,bhtsd->bhts', qc, kc, decay)
        o = jnp.einsum('bhts,bhsv->bhtv', att, vc) + jnp.einsum('bhtd,bhdv->bhtv', qc * jnp.exp(cum), s)
        last = cum[:, :, -1:, :]
        s_new = jnp.exp(last[:, :, 0, :])[..., None] * s + jnp.einsum('bhsd,bhsv->bhdv', kc * jnp.exp(last - cum), vc)
        return s_new, o

    s_fin, o = lax.scan(step, s0, (to_chunks(q), to_chunks(k), to_chunks(v), to_chunks(log_f)))
    return o.transpose(1, 0, 3, 2, 4).reshape(b, t, h, v.shape[-1]), s_fin


def hgrn2_mixer(lat, cxt, lb, o_gain, with_ctx_out):
    def heads(a):
        return a.reshape(a.shape[0], a.shape[1], B_HEADS, -1).astype(jnp.float32)

    def gates(f_pre, lbd):
        f = lbd + (1.0 - lbd) * jax.nn.sigmoid(heads(f_pre))
        return 1.0 - f, jnp.log(f)

    ql, ffl, fbl, il, gl = lat
    qc, ffc, fbc, ic, gc = cxt
    qscale = B_KEY_DIM ** -0.5
    qlh, ilh = heads(ql) * qscale, heads(il)
    qch, ich = heads(qc) * qscale, heads(ic)
    s0 = jnp.zeros((ql.shape[0], B_HEADS, B_KEY_DIM, B_VAL_DIM), jnp.float32)
    o_lat, o_ctx = None, None
    for f_l, f_c, lbd, reverse in ((ffl, ffc, lb[0], False), (fbl, fbc, lb[1], True)):
        rev = (lambda a: jnp.flip(a, axis=1)) if reverse else (lambda a: a)
        kl, lfl = gates(f_l, lbd)
        kc, lfc = gates(f_c, lbd)
        oc, s_ctx = gla_chunk_scan(rev(qch), rev(kc), rev(ich), rev(lfc), s0)
        ol, _ = gla_chunk_scan(rev(qlh), rev(kl), rev(ilh), rev(lfl), s_ctx)
        o_lat = rev(ol) if o_lat is None else o_lat + rev(ol)
        o_ctx = rev(oc) if o_ctx is None else o_ctx + rev(oc)

    def readout(o, g):
        y = rmsnorm(o, o_gain) * jax.nn.silu(heads(g))
        return y.reshape(g.shape[0], g.shape[1], BRANCH_WIDTH).astype(g.dtype)

    y = readout(o_lat, gl)
    if not with_ctx_out:
        return y, None
    return y, readout(o_ctx, gc)


def window_mean(x, w):
    t = x.shape[1]
    xf = x.astype(jnp.float32)
    cs = jnp.concatenate([jnp.zeros_like(xf[:, :1]), lax.cumsum(xf, axis=1)], axis=1)
    pos = jnp.arange(t)
    lo = jnp.clip(pos - w // 2, 0, t)
    hi = jnp.clip(pos - w // 2 + w, 0, t)
    mean = (cs[:, hi] - cs[:, lo]) / (hi - lo).astype(jnp.float32)[None, :, None]
    return mean.astype(x.dtype)


def pool_mixer(xp, w_group, scale):
    b, t, _ = xp.shape
    xg = xp.reshape(b, t, C_GROUPS, C_GROUP_DIM)
    pooled = jnp.stack([window_mean(xg[:, :, g], w) - xg[:, :, g] for g, w in enumerate(C_WINDOWS)], axis=2)
    y = jnp.einsum('btgc,gcd->btgd', pooled, w_group).reshape(b, t, BRANCH_WIDTH)
    return y * scale


def na_mixer(q, k, v, qc, kc, vc, rel_bias, with_ctx_out):
    b, t = q.shape[:2]
    rows = t // GRID_W
    wr = min(NA_WIN_R, rows)
    wc = NA_WIN_C

    def grid(a):
        return a.reshape(b, rows, GRID_W, D_HEADS, HEAD_DIM)

    qg, kg, vg = grid(q), grid(k), grid(v)
    n_ctx = kc.shape[1]
    kcx = kc.reshape(b, n_ctx, D_HEADS, HEAD_DIM)
    vcx = vc.reshape(b, n_ctx, D_HEADS, HEAD_DIM)
    col = jnp.arange(GRID_W)
    col_idx = jnp.clip(col - wc // 2, 0, GRID_W - wc)[:, None] + jnp.arange(wc)
    dc_idx = col_idx - col[:, None] + (NA_WIN_C - 1)

    def row_block(r):
        rs = jnp.clip(r - wr // 2, 0, rows - wr)
        k_win = lax.dynamic_slice_in_dim(kg, rs, wr, axis=1)[:, :, col_idx]
        v_win = lax.dynamic_slice_in_dim(vg, rs, wr, axis=1)[:, :, col_idx]
        q_row = lax.dynamic_index_in_dim(qg, r, axis=1, keepdims=False)
        dr_idx = rs + jnp.arange(wr) - r + (NA_WIN_R - 1)
        bias = rel_bias[:, dr_idx][:, :, dc_idx]
        bias = jnp.transpose(bias, (0, 2, 1, 3)).reshape(D_HEADS, GRID_W, wr * wc).astype(jnp.float32)
        s_loc = jnp.einsum('bqhd,bwqjhd->bhqwj', q_row, k_win).reshape(b, D_HEADS, GRID_W, wr * wc)
        s_loc = s_loc.astype(jnp.float32) * ATTN_SCALE + bias
        s_ctx = jnp.einsum('bqhd,bkhd->bhqk', q_row, kcx).astype(jnp.float32) * ATTN_SCALE
        p = jax.nn.softmax(jnp.concatenate([s_ctx, s_loc], axis=-1), axis=-1).astype(v.dtype)
        p_ctx = p[..., :n_ctx]
        p_loc = p[..., n_ctx:].reshape(b, D_HEADS, GRID_W, wr, wc)
        return jnp.einsum('bhqk,bkhd->bqhd', p_ctx, vcx) + jnp.einsum('bhqwj,bwqjhd->bqhd', p_loc, v_win)

    o = lax.map(row_block, jnp.arange(rows))
    y = jnp.moveaxis(o, 0, 1).reshape(b, t, BRANCH_WIDTH)
    if not with_ctx_out:
        return y, None
    qcx = qc.reshape(b, n_ctx, D_HEADS, 1, HEAD_DIM)
    yc = dense_attend(qcx, kcx, vcx).reshape(b, n_ctx, BRANCH_WIDTH)
    return y, yc


def merge_branches(branches, gate_pre, w_branch, w_out):
    gates = jax.nn.sigmoid(gate_pre).reshape(gate_pre.shape[0], gate_pre.shape[1], N_BRANCH, D_MODEL)
    merged = gates[..., 0, :] * (branches[0] @ w_branch[0])
    for n in range(1, N_BRANCH):
        merged = merged + gates[..., n, :] * (branches[n] @ w_branch[n])
    return merged @ w_out


def token_mixing(xn, cn, w_in, a_q_norm, a_k_norm, lb, b_o_norm, c_w_group, c_scale, d_rel_bias,
                 w_branch, w_out, rope, with_ctx_out):
    offs = np.cumsum(IN_SPLITS)[:-1].tolist()
    pl = jnp.split(xn @ w_in, offs, axis=-1)
    pc = jnp.split(cn @ w_in, offs, axis=-1)
    ya, ya_c = gqa_mixer(pl[0], pl[1], pl[2], pc[0], pc[1], pc[2], a_q_norm, a_k_norm, rope, with_ctx_out)
    yb, yb_c = hgrn2_mixer(pl[3:8], pc[3:8], lb, b_o_norm, with_ctx_out)
    yp = pool_mixer(pl[8], c_w_group, c_scale)
    yd, yd_c = na_mixer(pl[9], pl[10], pl[11], pc[9], pc[10], pc[11], d_rel_bias, with_ctx_out)
    y_lat = merge_branches((ya, yb, yp, yd), pl[12], w_branch, w_out)
    if not with_ctx_out:
        return y_lat, None
    yp_c = pool_mixer(pc[8], c_w_group, c_scale)
    y_ctx = merge_branches((ya_c, yb_c, yp_c, yd_c), pc[12], w_branch, w_out)
    return y_lat, y_ctx


def setup_inputs(seed: int = 0) -> dict:
    key = jax.random.key(seed)
    ks = jax.random.split(key, 26)
    L, D = DEPTH, D_MODEL

    def w(k, shape, fan_in, gain=1.0):
        return jax.random.normal(k, shape, jnp.float32) * (gain * fan_in ** -0.5)

    def g(k, shape):
        return 1.0 + 0.02 * jax.random.normal(k, shape, jnp.float32)

    def nrm(k, shape, s):
        return s * jax.random.normal(k, shape, jnp.float32)

    return {
        'x': nrm(ks[0], (BATCH, SEQ, D), 1.0),
        'c': nrm(ks[1], (BATCH, D), 1.0),
        'ctx': nrm(ks[2], (BATCH, CTX_LEN, D), 1.0),
        'c_ctx': nrm(ks[3], (D,), 1.0),
        'w_ada': w(ks[4], (L, D, N_MOD * D), D, 0.5),
        'b_ada': nrm(ks[5], (L, N_MOD * D), 0.01),
        'ffn1_norm': g(ks[6], (L, D)),
        'ffn1_w_gate': w(ks[7], (L, D, D_FF), D),
        'ffn1_w_up': w(ks[8], (L, D, D_FF), D),
        'ffn1_w_down': w(ks[9], (L, D_FF, D), D_FF),
        'mix_norm': g(ks[10], (L, D)),
        'w_in': w(ks[11], (L, D, IN_WIDTH), D),
        'a_q_norm': g(ks[12], (L, HEAD_DIM)),
        'a_k_norm': g(ks[13], (L, HEAD_DIM)),
        'b_lb_logits': nrm(ks[14], (L, 2, B_HEADS * B_KEY_DIM), 0.5),
        'b_o_norm': g(ks[15], (L, B_VAL_DIM)),
        'c_w_group': w(ks[16], (L, C_GROUPS, C_GROUP_DIM, C_GROUP_DIM), C_GROUP_DIM),
        'c_scale': g(ks[17], (L, BRANCH_WIDTH)),
        'd_rel_bias': nrm(ks[18], (L, D_HEADS, 2 * NA_WIN_R - 1, 2 * NA_WIN_C - 1), 0.1),
        'w_branch': w(ks[19], (L, N_BRANCH, BRANCH_WIDTH, D), BRANCH_WIDTH),
        'w_out': w(ks[20], (L, D, D), D),
        'ffn2_norm': g(ks[21], (L, D)),
        'ffn2_w_gate': w(ks[22], (L, D, D_FF), D),
        'ffn2_w_up': w(ks[23], (L, D, D_FF), D),
        'ffn2_w_down': w(ks[24], (L, D_FF, D), D_FF),
        'final_norm': g(ks[25], (D,)),
    }


def reference(x, c, ctx, c_ctx, w_ada, b_ada, ffn1_norm, ffn1_w_gate, ffn1_w_up, ffn1_w_down,
              mix_norm, w_in, a_q_norm, a_k_norm, b_lb_logits, b_o_norm, c_w_group, c_scale,
              d_rel_bias, w_branch, w_out, ffn2_norm, ffn2_w_gate, ffn2_w_up, ffn2_w_down, final_norm):
    rope = rope_tables(x.shape[1])
    lb_all = jnp.cumsum(jax.nn.softmax(b_lb_logits.astype(jnp.float32), axis=0), axis=0)
    lb_all = (lb_all - lb_all[:1]).reshape(DEPTH, 2, B_HEADS, B_KEY_DIM)
    h = ctx
    for l in range(DEPTH):
        with_ctx_out = l < DEPTH - 1
        mod = [m[:, None, :] for m in jnp.split(jax.nn.silu(c) @ w_ada[l] + b_ada[l], N_MOD, axis=-1)]
        mod_c = jnp.split(jax.nn.silu(c_ctx) @ w_ada[l] + b_ada[l], N_MOD, axis=-1)
        x = ffn_half(x, mod[0], mod[1], mod[2], ffn1_norm[l], ffn1_w_gate[l], ffn1_w_up[l], ffn1_w_down[l])
        h = ffn_half(h, mod_c[0], mod_c[1], mod_c[2], ffn1_norm[l], ffn1_w_gate[l], ffn1_w_up[l], ffn1_w_down[l])
        xn = modulate(rmsnorm(x, mix_norm[l]), mod[3], mod[4])
        hn = modulate(rmsnorm(h, mix_norm[l]), mod_c[3], mod_c[4])
        y, y_c = token_mixing(xn, hn, w_in[l], a_q_norm[l], a_k_norm[l], lb_all[l], b_o_norm[l],
                              c_w_group[l], c_scale[l], d_rel_bias[l], w_branch[l], w_out[l], rope, with_ctx_out)
        x = x + mod[5] * y
        x = ffn_half(x, mod[6], mod[7], mod[8], ffn2_norm[l], ffn2_w_gate[l], ffn2_w_up[l], ffn2_w_down[l])
        if with_ctx_out:
            h = h + mod_c[5] * y_c
            h = ffn_half(h, mod_c[6], mod_c[7], mod_c[8], ffn2_norm[l], ffn2_w_gate[l], ffn2_w_up[l], ffn2_w_down[l])
    return rmsnorm(x, final_norm)
```

```cpp
#include <hip/hip_runtime.h>
#include <hip/hip_cooperative_groups.h>
#include <cstdio>
#include <cstdint>
namespace cg = cooperative_groups;

#ifndef MK_PER_PHASE
#define MK_PER_PHASE 0
#endif

#ifndef PROBE_DBL
#define PROBE_DBL 0
#endif
#ifndef PHM
#define PHM 0xffff
#endif
#define LAS __attribute__((address_space(3)))
typedef unsigned short bf16_t;
typedef short bf16x8 __attribute__((ext_vector_type(8)));
typedef short s16x4 __attribute__((ext_vector_type(4)));
typedef float f32x4 __attribute__((ext_vector_type(4)));
typedef float f32x16 __attribute__((ext_vector_type(16)));
typedef unsigned u32x4 __attribute__((ext_vector_type(4)));
typedef unsigned u32x2 __attribute__((ext_vector_type(2)));

constexpr int D = 1024, SEQ = 16384, CTX = 256, NTOK = SEQ + CTX, DEPTH = 4, DFF = 2816, INW = 6912, NMODV = 9 * 1024;
constexpr int C_AQ = 0, C_AK = 256, C_AV = 384, C_BQ = 512, C_BFF = 768, C_BFB = 1024, C_BI = 1280, C_BG = 1536, C_CX = 1792, C_DQ = 2048, C_DK = 2304, C_DV = 2560, C_GATE = 2816;
constexpr int NCHUNK = NTOK / 64;
constexpr float EPSN = 1e-6f;
constexpr float LOG2E = 1.4426950408889634f;
constexpr float ATT_SCALE = 0.125f;

constexpr size_t O_WGU1 = 0, O_WD1 = O_WGU1 + (size_t)2 * DFF * D, O_WIN = O_WD1 + (size_t)D * DFF, O_WB = O_WIN + (size_t)INW * D, O_WO4 = O_WB + (size_t)4096 * 256,
                 O_WGU2 = O_WO4 + (size_t)1024 * 1024, O_WD2 = O_WGU2 + (size_t)2 * DFF * D, LAYER_W = O_WD2 + (size_t)D * DFF;
constexpr size_t WS_W = 1u << 20;
constexpr size_t WS_MOD = WS_W + LAYER_W * 2 * DEPTH;
constexpr size_t WS_X = WS_MOD + (size_t)DEPTH * 2 * NMODV * 4 + 1024;
constexpr size_t WS_XN = WS_X + (size_t)NTOK * D * 4;
constexpr size_t WS_HA = WS_XN + (size_t)NTOK * D * 2;
constexpr size_t WS_PB = WS_HA + (size_t)2 * NCHUNK * 4 * 64 * 4;
constexpr size_t WS_Y = WS_PB + (size_t)NTOK * INW * 2;
constexpr size_t WS_VTA = WS_Y + (size_t)NTOK * D * 2;
constexpr size_t WS_VTD = WS_VTA + (size_t)2 * 64 * NTOK * 2;
constexpr size_t WS_PART = WS_VTD + (size_t)4 * 64 * NTOK * 2;
constexpr size_t WS_END = WS_PART + (size_t)11 * 256 * 1024 * 4;
static_assert(WS_X % 256 == 0 && WS_XN % 256 == 0 && WS_PB % 256 == 0 && WS_Y % 256 == 0 && WS_VTA % 256 == 0, "ws align");
static_assert((size_t)2 * NCHUNK * 4 * 4096 * 4 <= (size_t)NTOK * D * 2, "GS overlay fits XN");

constexpr int LDS_BYTES = 148480;
constexpr int NSUB = 14;
constexpr int NPHASE = 1 + NSUB * DEPTH + 1;

__device__ __forceinline__ float bf2f(unsigned v) { return __uint_as_float(v << 16); }
typedef __bf16 bf16x2_t __attribute__((ext_vector_type(2)));
typedef float f32x2_t __attribute__((ext_vector_type(2)));
__device__ __forceinline__ unsigned pk2(float lo, float hi) { const f32x2_t v = {lo, hi}; const bf16x2_t b = __builtin_convertvector(v, bf16x2_t); return __builtin_bit_cast(unsigned, b); }
__device__ __forceinline__ unsigned f2bf(float f) { return pk2(f, 0.f) & 0xffffu; }
__device__ __forceinline__ float lo16(unsigned w) { return __uint_as_float(w << 16); }
__device__ __forceinline__ float hi16(unsigned w) { return __uint_as_float(w & 0xffff0000u); }
__device__ __forceinline__ float max3f(float a, float b, float c) { float r; asm("v_max3_f32 %0, %1, %2, %3" : "=v"(r) : "v"(a), "v"(b), "v"(c)); return r; }
template <int K> __device__ __forceinline__ float swz_xor(float v) { return __uint_as_float((unsigned)__builtin_amdgcn_ds_swizzle((int)__float_as_uint(v), (K << 10) | 0x1f)); }
__device__ __forceinline__ float xor32_sum(float v) { const auto rr = __builtin_amdgcn_permlane32_swap(__float_as_uint(v), __float_as_uint(v), false, false); return __uint_as_float(rr[0]) + __uint_as_float(rr[1]); }
__device__ __forceinline__ float xor32_max(float v) { const auto rr = __builtin_amdgcn_permlane32_swap(__float_as_uint(v), __float_as_uint(v), false, false); return fmaxf(__uint_as_float(rr[0]), __uint_as_float(rr[1])); }
__device__ __forceinline__ float wave_sum(float v) {
    v += swz_xor<1>(v); v += swz_xor<2>(v); v += swz_xor<4>(v); v += swz_xor<8>(v); v += swz_xor<16>(v);
    return xor32_sum(v);
}
__device__ __forceinline__ float sigmoidf_(float x) { return __builtin_amdgcn_rcpf(1.0f + __builtin_amdgcn_exp2f(-1.4426950408889634f * x)); }
__device__ __forceinline__ float siluf_(float x) { return x * __builtin_amdgcn_rcpf(1.0f + __builtin_amdgcn_exp2f(-1.4426950408889634f * x)); }

__device__ __forceinline__ void fadd_agent(float* p, float v) { (void)__hip_atomic_fetch_add(p, v, __ATOMIC_RELAXED, __HIP_MEMORY_SCOPE_AGENT); }

namespace pg8 {
constexpr int BM = 256, BK = 64, HALF = 128, HTB = HALF * BK * 2, STAGE_BYTES = 8 * HTB, NXCD = 8, WGM = 8, WGMS = 4;
__host__ __device__ __forceinline__ int lds_byte(int r, int c) { const int st = (r >> 4) * 2 + (c >> 5), rr = r & 15, cc = c & 31, ob = rr * 64 + cc * 2; return st * 1024 + (ob ^ (((ob >> 9) & 1) << 5)); }
__host__ __device__ __forceinline__ void stage_rc(int b, int& R, int& C) { const int st = b / 1024, sb = b % 1024, swz = sb ^ (((sb >> 9) & 1) << 5); R = (st >> 1) * 16 + swz / 64; C = (st & 1) * 32 + (swz % 64) / 2; }
__host__ __device__ __forceinline__ int perm32(int rho) { const int n = rho >> 4, i = rho & 15; return 8 * (i >> 2) + 4 * n + (i & 3); }

struct Unit { int pm, pn, kt0, nkt; };
struct Gemm { const bf16_t* A; const bf16_t* Bt; int M, N, K, lda, a_sh, a_str; };

struct StaticOrder {
    int nM, nN, nwg, G, c, nkt;
    __host__ __device__ void init(int M, int N, int K, int G_, int c_) { nM = M / BM; nN = N / BM; nwg = nM * nN; G = G_; c = c_; nkt = K / BK; }
    __host__ __device__ bool next(int i, Unit& u) const {
        const long L = (long)i * G + c; if (L >= nwg) return false;
        int wgid = (int)L; { const int q = nwg / NXCD, r = nwg % NXCD, xcd = wgid % NXCD, off = wgid / NXCD; wgid = (xcd < r ? xcd * (q + 1) : r * (q + 1) + (xcd - r) * q) + off; }
        const int nig = WGMS * nN, gid = wgid / nig, fm = gid * WGMS, gsz = (nM - fm) < WGMS ? (nM - fm) : WGMS;
        u.pm = fm + ((wgid % nig) % gsz); u.pn = (wgid % nig) / gsz; u.kt0 = 0; u.nkt = nkt; return true;
    }
};
struct ResidOrder {
    int G, c, nkt, ksplit;
    __host__ __device__ void init(int K, int ksplit_, int G_, int c_) { G = G_; c = c_; nkt = K / BK; ksplit = ksplit_; }
    __host__ __device__ bool next(int i, Unit& u) const {
        const long L = (long)i * G + c;
        const bool lat = L < 256; const int Lc = (int)L - 256;
        int wgid = (int)(L & 255); wgid = (wgid % NXCD) * (256 / NXCD) + wgid / NXCD;
        const int nig = WGM * 4, fm = (wgid / nig) * WGM;
        const int pm_l = fm + ((wgid % nig) % WGM), pn_l = (wgid % nig) / WGM, nk_s = nkt / ksplit;
        u.pm = lat ? pm_l : SEQ / BM; u.pn = lat ? pn_l : (Lc & 3); u.nkt = lat ? nkt : nk_s; u.kt0 = lat ? 0 : (Lc >> 2) * nk_s;
        return lat || (Lc < 4 * ksplit);
    }
};


struct EpiSwiglu {
    static constexpr bool PERM = false;
    bf16_t* H;
    __device__ __forceinline__ void operator()(const f32x4 (&acc)[2][2][4][2], const Unit& u, int wr, int wc, int fr, int fq) const {
        const int row0 = u.pm * BM + wr * 64 + fr;
#pragma unroll
        for (int ai = 0; ai < 2; ++ai)
#pragma unroll
            for (int m = 0; m < 4; ++m) {
                bf16_t* rowp = H + (size_t)(row0 + ai * HALF + m * 16) * DFF;
#pragma unroll
                for (int bj = 0; bj < 2; ++bj) {
                    const int hid = (u.pn * 8 + bj * 4 + wc) * 16 + 4 * fq;
                    const f32x4 g = acc[ai][bj][m][0], up = acc[ai][bj][m][1];
                    u32x2 w; w.x = pk2(siluf_(g[0]) * up[0], siluf_(g[1]) * up[1]); w.y = pk2(siluf_(g[2]) * up[2], siluf_(g[3]) * up[3]);
                    *(u32x2*)(rowp + hid) = w;
                }
            }
    }
};
struct EpiResid {
    static constexpr bool PERM = false;
    float* X; const float* modl; int sel; float coef; int nkt_full; float* part; int ksh;
    __device__ __forceinline__ void operator()(const f32x4 (&acc)[2][2][4][2], const Unit& u, int wr, int wc, int fr, int fq) const {
        const float* mv = modl + (u.pm == (SEQ / BM) ? NMODV : 0) + sel * 1024;
        const int col0 = u.pn * BM + wc * 32 + 4 * fq;
        const bool split = u.nkt != nkt_full;
        float* base = split ? part + ((ptrdiff_t)(u.kt0 >> ksh) * 256 - (ptrdiff_t)u.pm * BM) * D : X;
#pragma unroll
        for (int bj = 0; bj < 2; ++bj)
#pragma unroll
            for (int n = 0; n < 2; ++n) {
                const f32x4 gv = *(const f32x4*)(mv + col0 + bj * HALF + n * 16) * coef;
#pragma unroll
                for (int ai = 0; ai < 2; ++ai)
#pragma unroll
                    for (int m = 0; m < 4; ++m) {
                        float* p = base + (size_t)(u.pm * BM + ai * HALF + wr * 64 + m * 16 + fr) * D + col0 + bj * HALF + n * 16;
                        const f32x4 dv = gv * acc[ai][bj][m][n];
                        if (split) *(f32x4*)p = dv;
                        else { const f32x4 xo = *(const f32x4*)p; *(f32x4*)p = xo + dv; }
                    }
            }
    }
};
struct EpiPlain {
    static constexpr bool PERM = true;
    bf16_t* O; int ldc;
    __device__ __forceinline__ void operator()(const f32x4 (&acc)[2][2][4][2], const Unit& u, int wr, int wc, int fr, int fq) const {
        const int row0 = u.pm * BM + wr * 64 + fr, col0 = u.pn * BM + wc * 32 + 8 * fq;
#pragma unroll
        for (int ai = 0; ai < 2; ++ai)
#pragma unroll
            for (int m = 0; m < 4; ++m) {
                bf16_t* rowp = O + (size_t)(row0 + ai * HALF + m * 16) * ldc + col0;
#pragma unroll
                for (int bj = 0; bj < 2; ++bj) {
                    const f32x4 v0 = acc[ai][bj][m][0], v1 = acc[ai][bj][m][1];
                    u32x4 w; w.x = pk2(v0[0], v0[1]); w.y = pk2(v0[2], v0[3]); w.z = pk2(v1[0], v1[1]); w.w = pk2(v1[2], v1[3]);
                    *(u32x4*)(rowp + bj * HALF) = w;
                }
            }
    }
};
struct EpiGate {
    static constexpr bool PERM = true;
    bf16_t* O; int ldc;
    __device__ __forceinline__ void operator()(const f32x4 (&acc)[2][2][4][2], const Unit& u, int wr, int wc, int fr, int fq) const {
        const int row0 = u.pm * BM + wr * 64 + fr, col0 = u.pn * BM + wc * 32 + 8 * fq;
#pragma unroll
        for (int ai = 0; ai < 2; ++ai)
#pragma unroll
            for (int m = 0; m < 4; ++m) {
                bf16_t* rowp = O + (size_t)(row0 + ai * HALF + m * 16) * ldc + col0;
#pragma unroll
                for (int bj = 0; bj < 2; ++bj) {
                    u32x4 gp = *(const u32x4*)(rowp + bj * HALF);
                    const f32x4 v0 = acc[ai][bj][m][0], v1 = acc[ai][bj][m][1];
                    gp.x = pk2(sigmoidf_(lo16(gp.x)) * v0[0], sigmoidf_(hi16(gp.x)) * v0[1]); gp.y = pk2(sigmoidf_(lo16(gp.y)) * v0[2], sigmoidf_(hi16(gp.y)) * v0[3]);
                    gp.z = pk2(sigmoidf_(lo16(gp.z)) * v1[0], sigmoidf_(hi16(gp.z)) * v1[1]); gp.w = pk2(sigmoidf_(lo16(gp.w)) * v1[2], sigmoidf_(hi16(gp.w)) * v1[3]);
                    *(u32x4*)(rowp + bj * HALF) = gp;
                    asm volatile("" ::: "memory");
                }
            }
    }
};

template <class Epi, class Sched>
__device__ __forceinline__ void gemm_phase(LAS unsigned char* lds, const Gemm g, const Sched& S, const Epi& E, const int tid) {
    const int wid = __builtin_amdgcn_readfirstlane(tid >> 6), lane = tid & 63, wr = wid >> 2, wc = wid & 3, fr = lane & 15, fq = lane >> 4;
    const int K = g.K, lda = g.lda;
    unsigned voffA[2], voffB[2];
#pragma unroll
    for (int i = 0; i < 2; ++i) { int R, C; stage_rc(tid * 16 + i * 8192, R, C); const int Rb = Epi::PERM ? ((R & ~31) + perm32(R & 31)) : R;
        voffA[i] = (unsigned)(R * lda + C) * 2u; voffB[i] = (unsigned)(Rb * K + C) * 2u; }
    const size_t kstep = (size_t)(BK * 2);
    const size_t hstepA = (size_t)HALF * lda * 2, hstepB = (size_t)HALF * K * 2;
    const size_t tstepA = 2 * hstepA, tstepB = 2 * hstepB;
    const unsigned ldsw = (unsigned)wid * 1024u;
    const int aoff = lds_byte(wr * 64 + fr, fq * 8), boff = lds_byte(wc * 32 + fr, fq * 8);
#define PG8_UA(u) ((const char*)g.A + (size_t)(u).pm * tstepA + (size_t)(((u).pn >> g.a_sh) * g.a_str) + (size_t)(u).kt0 * kstep)
#define PG8_UB(u) ((const char*)g.Bt + (size_t)(u).pn * tstepB + (size_t)(u).kt0 * kstep)
#define PG8_SA(b, h) (((b) * 2 + (h)) * HTB)
#define PG8_SB(b, h) ((4 + (b) * 2 + (h)) * HTB)
#define PG8_STAGE(bufoff, gbase, voff) do { _Pragma("unroll") for (int _i = 0; _i < 2; ++_i) \
        __builtin_amdgcn_global_load_lds((const unsigned*)((const char*)(gbase) + (voff)[_i]), (LAS unsigned*)(lds + (bufoff) + ldsw + _i * 8192), 16, 0, 0); } while (0)
#define PG8_LDA(dst, b, h) do { _Pragma("unroll") for (int m = 0; m < 4; ++m) _Pragma("unroll") for (int k = 0; k < 2; ++k) dst[m][k] = *(const LAS bf16x8*)(lds + PG8_SA(b, h) + aoff + m * 2048 + k * 1024); } while (0)
#define PG8_LDB(dst, b, h) do { _Pragma("unroll") for (int n = 0; n < 2; ++n) _Pragma("unroll") for (int k = 0; k < 2; ++k) dst[n][k] = *(const LAS bf16x8*)(lds + PG8_SB(b, h) + boff + n * 2048 + k * 1024); } while (0)
#define PG8_MMA(ai, bj, At, Bt) do { __builtin_amdgcn_s_setprio(1); _Pragma("unroll") for (int m = 0; m < 4; ++m) _Pragma("unroll") for (int n = 0; n < 2; ++n) _Pragma("unroll") for (int k = 0; k < 2; ++k) \
        acc[ai][bj][m][n] = __builtin_amdgcn_mfma_f32_16x16x32_bf16(Bt[n][k], At[m][k], acc[ai][bj][m][n], 0, 0, 0); __builtin_amdgcn_s_setprio(0); } while (0)
#define PG8_WAIT_V(n) asm volatile("s_waitcnt vmcnt(" #n ")" ::: "memory")
#define PG8_WAIT_L(n) asm volatile("s_waitcnt lgkmcnt(" #n ")" ::: "memory")
#define PG8_BAR __builtin_amdgcn_s_barrier()
#define PG8_SCHED __builtin_amdgcn_sched_barrier(0)
    Unit cur, nxt; int ui = 0;
    if (!S.next(0, cur)) return;
    f32x4 acc[2][2][4][2];
#pragma unroll
    for (int a = 0; a < 2; ++a)
#pragma unroll
        for (int b = 0; b < 2; ++b)
#pragma unroll
            for (int m = 0; m < 4; ++m)
#pragma unroll
                for (int n = 0; n < 2; ++n) acc[a][b][m][n] = (f32x4){0.f, 0.f, 0.f, 0.f};
    bf16x8 At[4][2], B0[2][2], B1[2][2];
    const char* cA = PG8_UA(cur); const char* cB = PG8_UB(cur);
    PG8_STAGE(PG8_SB(0, 0), cB, voffB); PG8_STAGE(PG8_SB(0, 1), cB + hstepB, voffB); PG8_STAGE(PG8_SA(0, 0), cA, voffA); PG8_STAGE(PG8_SA(0, 1), cA + hstepA, voffA);
    if (wr == 1) PG8_BAR;
    PG8_WAIT_V(2); PG8_BAR;
    PG8_STAGE(PG8_SB(1, 0), cB + kstep, voffB); PG8_STAGE(PG8_SA(1, 0), cA + kstep, voffA); PG8_STAGE(PG8_SB(1, 1), cB + hstepB + kstep, voffB);
    PG8_WAIT_V(6); PG8_BAR;
    for (;;) {
        const bool has_next = S.next(ui + 1, nxt);
        const char* nA = has_next ? PG8_UA(nxt) : cA; const char* nB = has_next ? PG8_UB(nxt) : cB;
        const int nt = cur.nkt;
#pragma unroll 1
        for (int t = 0; t < nt; t += 2) {
            const bool last = (t == nt - 2);
            const char* a1 = cA + (size_t)(t + 1) * kstep;
            const char* a2 = last ? nA : cA + (size_t)(t + 2) * kstep; const char* b2 = last ? nB : cB + (size_t)(t + 2) * kstep;
            const char* a3 = a2 + kstep; const char* b3 = b2 + kstep;
            PG8_LDB(B0, 0, 0); PG8_LDB(B1, 0, 1); PG8_SCHED; PG8_LDA(At, 0, 0); PG8_STAGE(PG8_SA(1, 1), a1 + hstepA, voffA);
            PG8_WAIT_V(8); PG8_WAIT_L(0); PG8_BAR; PG8_MMA(0, 0, At, B0); PG8_MMA(0, 1, At, B1); PG8_BAR; PG8_SCHED;
            PG8_LDA(At, 0, 1); PG8_STAGE(PG8_SB(0, 0), b2, voffB); PG8_STAGE(PG8_SB(0, 1), b2 + hstepB, voffB); PG8_STAGE(PG8_SA(0, 0), a2, voffA);
            PG8_WAIT_V(8); PG8_WAIT_L(0); PG8_BAR; PG8_MMA(1, 0, At, B0); PG8_MMA(1, 1, At, B1); PG8_BAR; PG8_SCHED;
            PG8_LDB(B0, 1, 0); PG8_LDB(B1, 1, 1); PG8_SCHED; PG8_LDA(At, 1, 0); PG8_STAGE(PG8_SA(0, 1), a2 + hstepA, voffA);
            PG8_WAIT_V(8); PG8_WAIT_L(0); PG8_BAR; PG8_MMA(0, 0, At, B0); PG8_MMA(0, 1, At, B1); PG8_BAR; PG8_SCHED;
            PG8_LDA(At, 1, 1); PG8_STAGE(PG8_SB(1, 0), b3, voffB); PG8_STAGE(PG8_SB(1, 1), b3 + hstepB, voffB); PG8_STAGE(PG8_SA(1, 0), a3, voffA);
            PG8_WAIT_V(8); PG8_WAIT_L(0); PG8_BAR; PG8_MMA(1, 0, At, B0); PG8_MMA(1, 1, At, B1); PG8_BAR; PG8_SCHED;
        }
        if (wr == 0) PG8_BAR;
        E(acc, cur, wr, wc, fr, fq);
        if (!has_next) break;
#pragma unroll
        for (int a = 0; a < 2; ++a)
#pragma unroll
            for (int b = 0; b < 2; ++b)
#pragma unroll
                for (int m = 0; m < 4; ++m)
#pragma unroll
                    for (int n = 0; n < 2; ++n) acc[a][b][m][n] = (f32x4){0.f, 0.f, 0.f, 0.f};
        cur = nxt; cA = nA; cB = nB; ++ui;
        if (wr == 1) PG8_BAR;
    }
    PG8_WAIT_V(0);
    PG8_BAR;
#undef PG8_UA
#undef PG8_UB
#undef PG8_SA
#undef PG8_SB
#undef PG8_STAGE
#undef PG8_LDA
#undef PG8_LDB
#undef PG8_MMA
#undef PG8_WAIT_V
#undef PG8_WAIT_L
#undef PG8_BAR
#undef PG8_SCHED
}
}

struct Args {
    const float* in[26];
    float* out; unsigned char* ws;
    int ph_lo, ph_hi;
};
__device__ __forceinline__ const float* in_ptr(int i) {
    const __attribute__((address_space(4))) char* ka = (const __attribute__((address_space(4))) char*)__builtin_amdgcn_kernarg_segment_ptr();
    int off = i * 8; asm volatile("" : "+s"(off));
    return *(const float* const __attribute__((address_space(4)))*)(ka + off);
}
struct Ctx {
    LAS unsigned char* lds;
    int tid, lane, wave, G, bid, gw, ngw;
};

__device__ __forceinline__ void transpose_item(const float* __restrict__ W, int K, int N, bf16_t* __restrict__ WT, int ldw, int koff, int row_off, int mode, LAS float* scr, int item, int lane) {
    const int nblk = N / 32, kb = item / nblk, nb = item % nblk, k0 = 64 * kb, n0 = 32 * nb;
#pragma unroll
    for (int i = 0; i < 32; ++i) { const int kk = 2 * i + (lane >> 5); scr[kk * 33 + (lane & 31)] = W[(size_t)(k0 + kk) * N + n0 + (lane & 31)]; }
    asm volatile("s_waitcnt lgkmcnt(0)" ::: "memory");
    const int c = lane & 7;
#pragma unroll
    for (int j = 0; j < 4; ++j) { const int n = (lane >> 3) + 8 * j; const LAS float* s = scr + (8 * c) * 33 + n;
        u32x4 o; o.x = pk2(s[0 * 33], s[1 * 33]); o.y = pk2(s[2 * 33], s[3 * 33]); o.z = pk2(s[4 * 33], s[5 * 33]); o.w = pk2(s[6 * 33], s[7 * 33]);
        const int ng = n0 + n;
        const int dr = mode == 0 ? ng : (((ng >> 4) << 5) + (ng & 15) + (mode == 2 ? 16 : 0));
        *(u32x4*)(WT + (size_t)(row_off + dr) * ldw + koff + k0 + 8 * c) = o; }
    asm volatile("s_waitcnt lgkmcnt(0)" ::: "memory");
}

__device__ __forceinline__ void phase0(const Ctx& F, const Args& a) {
    unsigned char* ws = a.ws;
    {
        LAS float* sc = (LAS float*)F.lds;
        const float* cvec = in_ptr(1); const float* cctx = in_ptr(3); const float* w_ada = in_ptr(4); const float* b_ada = in_ptr(5);
        float* MOD = (float*)(ws + WS_MOD);
        for (int k = F.tid; k < 2048; k += 512) { const float c = (k < 1024) ? cvec[k] : cctx[k - 1024]; sc[k] = siluf_(c); }
        __syncthreads();
        LAS float* red = sc + 2048;
        for (int it = F.bid; it < DEPTH * 144; it += F.G) {
            const int l = it / 144, n = (it % 144) * 64 + F.lane, k0 = F.wave * 128;
            const float* w = w_ada + (size_t)l * D * NMODV + (size_t)k0 * NMODV + n; float a0 = 0.f, a1 = 0.f;
#pragma unroll 16
            for (int k = 0; k < 128; ++k) { const float wv = w[(size_t)k * NMODV]; a0 += sc[k0 + k] * wv; a1 += sc[1024 + k0 + k] * wv; }
            red[(F.wave * 2 + 0) * 64 + F.lane] = a0; red[(F.wave * 2 + 1) * 64 + F.lane] = a1;
            __syncthreads();
            if (F.wave < 2) { float s = b_ada[l * NMODV + n];
#pragma unroll
                for (int ww = 0; ww < 8; ++ww) s += red[(ww * 2 + F.wave) * 64 + F.lane];
                MOD[(size_t)(l * 2 + F.wave) * NMODV + n] = s; }
            __syncthreads();
        }
    }
    {
        LAS float* scr = (LAS float*)(F.lds + F.wave * 16384);
        constexpr int I_FF = 16 * 88, I_DN = 44 * 32, I_IN = 16 * 216, I_B = 4 * 32, I_O = 16 * 32;
        constexpr int PER_LAYER = 4 * I_FF + 2 * I_DN + I_IN + 4 * I_B + I_O;
        for (int it = F.gw; it < PER_LAYER * DEPTH; it += F.ngw) {
            const int l = it / PER_LAYER; int r = it % PER_LAYER;
            bf16_t* WL = (bf16_t*)(ws + WS_W) + (size_t)l * LAYER_W;
            if (r < I_FF) { transpose_item(in_ptr(7) + (size_t)l * D * DFF, D, DFF, WL + O_WGU1, D, 0, 0, 1, scr, r, F.lane); continue; } r -= I_FF;
            if (r < I_FF) { transpose_item(in_ptr(8) + (size_t)l * D * DFF, D, DFF, WL + O_WGU1, D, 0, 0, 2, scr, r, F.lane); continue; } r -= I_FF;
            if (r < I_DN) { transpose_item(in_ptr(9) + (size_t)l * DFF * D, DFF, D, WL + O_WD1, DFF, 0, 0, 0, scr, r, F.lane); continue; } r -= I_DN;
            if (r < I_IN) { transpose_item(in_ptr(11) + (size_t)l * D * INW, D, INW, WL + O_WIN, D, 0, 0, 0, scr, r, F.lane); continue; } r -= I_IN;
            if (r < 4 * I_B) { const int b = r / I_B; transpose_item(in_ptr(19) + ((size_t)l * 4 + b) * 256 * D, 256, D, WL + O_WB, 256, 0, b * 1024, 0, scr, r % I_B, F.lane); continue; } r -= 4 * I_B;
            if (r < I_O) { transpose_item(in_ptr(20) + (size_t)l * D * D, D, D, WL + O_WO4, D, 0, 0, 0, scr, r, F.lane); continue; } r -= I_O;
            if (r < I_FF) { transpose_item(in_ptr(22) + (size_t)l * D * DFF, D, DFF, WL + O_WGU2, D, 0, 0, 1, scr, r, F.lane); continue; } r -= I_FF;
            if (r < I_FF) { transpose_item(in_ptr(23) + (size_t)l * D * DFF, D, DFF, WL + O_WGU2, D, 0, 0, 2, scr, r, F.lane); continue; } r -= I_FF;
            transpose_item(in_ptr(24) + (size_t)l * DFF * D, DFF, D, WL + O_WD2, DFF, 0, 0, 0, scr, r, F.lane);
        }
    }
    {
        f32x4* X4 = (f32x4*)(ws + WS_X); const f32x4* x4 = (const f32x4*)in_ptr(0); const f32x4* c4 = (const f32x4*)in_ptr(2);
        const size_t n1 = (size_t)SEQ * D / 4, n2 = (size_t)CTX * D / 4;
        for (size_t i = (size_t)F.bid * 512 + F.tid; i < n1 + n2; i += (size_t)F.G * 512) X4[i] = i < n1 ? x4[i] : c4[i - n1];
    }
}

__device__ __forceinline__ void norm_phase(const Ctx& F, float* X, const float* gw, const float* modl, int ish, int isc, bf16_t* XN, const float* part, int nsplit) {
    for (int row = SEQ + F.gw; row < NTOK; row += F.ngw) {
        const float* mv = modl + NMODV;
        f32x4* xr = (f32x4*)(X + (size_t)row * D) + F.lane;
        f32x4 v[4];
#pragma unroll
        for (int j = 0; j < 4; ++j) v[j] = xr[64 * j];
        const f32x4* pr = (const f32x4*)(part + (size_t)(row - SEQ) * D) + F.lane;
        int s = 0;
        for (; s + 4 <= nsplit; s += 4) {
            f32x4 t[4][4];
#pragma unroll
            for (int u = 0; u < 4; ++u)
#pragma unroll
                for (int j = 0; j < 4; ++j) t[u][j] = pr[(size_t)(s + u) * (256 * D / 4) + 64 * j];
#pragma unroll
            for (int u = 0; u < 4; ++u)
#pragma unroll
                for (int j = 0; j < 4; ++j) v[j] += t[u][j];
        }
        for (; s < nsplit; ++s)
#pragma unroll
            for (int j = 0; j < 4; ++j) v[j] += pr[(size_t)s * (256 * D / 4) + 64 * j];
        if (nsplit > 0) {
#pragma unroll
            for (int j = 0; j < 4; ++j) xr[64 * j] = v[j];
        }
        float ss = 0.f;
#pragma unroll
        for (int j = 0; j < 4; ++j) ss += (v[j].x * v[j].x + v[j].y * v[j].y) + (v[j].z * v[j].z + v[j].w * v[j].w);
        const float rs = __builtin_amdgcn_rsqf(wave_sum(ss) * (1.f / D) + EPSN);
#pragma unroll
        for (int j = 0; j < 4; ++j) {
            const int col = 4 * F.lane + 256 * j;
            const f32x4 g4 = *(const f32x4*)(gw + col), sh = *(const f32x4*)(mv + ish * 1024 + col), sc = *(const f32x4*)(mv + isc * 1024 + col);
            const f32x4 o = (v[j] * rs) * (g4 * (sc + 1.0f)) + sh;
            u32x2 w; w.x = pk2(o.x, o.y); w.y = pk2(o.z, o.w);
            *(u32x2*)(XN + (size_t)row * D + col) = w;
        }
    }
    for (int row0 = 4 * F.gw; row0 < SEQ; row0 += 4 * F.ngw) {
        const float* mv = modl;
        f32x4 v[4][4];
#pragma unroll
        for (int r = 0; r < 4; ++r) { const f32x4* xr = (const f32x4*)(X + (size_t)(row0 + r) * D) + F.lane;
#pragma unroll
            for (int j = 0; j < 4; ++j) v[r][j] = xr[64 * j]; }
        float rs[4];
#pragma unroll
        for (int r = 0; r < 4; ++r) { float ss = 0.f;
#pragma unroll
            for (int j = 0; j < 4; ++j) ss += (v[r][j].x * v[r][j].x + v[r][j].y * v[r][j].y) + (v[r][j].z * v[r][j].z + v[r][j].w * v[r][j].w);
            rs[r] = __builtin_amdgcn_rsqf(wave_sum(ss) * (1.f / D) + EPSN); }
#pragma unroll
        for (int j = 0; j < 4; ++j) {
            const int col = 4 * F.lane + 256 * j;
            const f32x4 g4 = *(const f32x4*)(gw + col), sh = *(const f32x4*)(mv + ish * 1024 + col), sc = *(const f32x4*)(mv + isc * 1024 + col);
            const f32x4 gs = g4 * (sc + 1.0f);
#pragma unroll
            for (int r = 0; r < 4; ++r) {
                const f32x4 o = (v[r][j] * rs[r]) * gs + sh;
                u32x2 w; w.x = pk2(o.x, o.y); w.y = pk2(o.z, o.w);
                *(u32x2*)(XN + (size_t)(row0 + r) * D + col) = w;
            }
        }
    }
}
__device__ __forceinline__ void final_norm_phase(const Ctx& F, const float* X, const float* gw, float* out) {
    for (int row = F.gw; row < SEQ; row += F.ngw) {
        const f32x4* xr = (const f32x4*)(X + (size_t)row * D) + F.lane;
        f32x4 v[4]; float ss = 0.f;
#pragma unroll
        for (int j = 0; j < 4; ++j) { v[j] = xr[64 * j]; ss += (v[j].x * v[j].x + v[j].y * v[j].y) + (v[j].z * v[j].z + v[j].w * v[j].w); }
        const float rs = 1.0f / sqrtf(wave_sum(ss) * (1.f / D) + EPSN);
#pragma unroll
        for (int j = 0; j < 4; ++j) { const int col = 4 * F.lane + 256 * j; *(f32x4*)(out + (size_t)row * D + col) = v[j] * rs * *(const f32x4*)(gw + col); }
    }
}

__device__ __forceinline__ void prep_qk(bf16_t* PB, int tok0, int col, const float* gain, bool rope, float outscale, int lane) {
    const int i = lane & 15, tq = lane >> 4;
    const float g0 = gain[i], g1 = gain[16 + i], g2 = gain[32 + i], g3 = gain[48 + i];
    const float inv = exp2f(-(float)i * 0.83048202372184059f);
#pragma unroll 4
    for (int pass = 0; pass < 16; ++pass) {
        const int tok = tok0 + pass * 4 + tq;
        bf16_t* p = PB + (size_t)tok * INW + col + i;
        float x0 = bf2f(p[0]), x1 = bf2f(p[16]), x2 = bf2f(p[32]), x3 = bf2f(p[48]);
        float ss = (x0 * x0 + x1 * x1) + (x2 * x2 + x3 * x3);
        ss += swz_xor<1>(ss); ss += swz_xor<2>(ss); ss += swz_xor<4>(ss); ss += swz_xor<8>(ss);
        const float r = 1.0f / sqrtf(ss * (1.f / 64.f) + EPSN);
        x0 = x0 * r * g0; x1 = x1 * r * g1; x2 = x2 * r * g2; x3 = x3 * r * g3;
        if (rope) {
            const float ar = (float)(tok >> 6) * inv, ac = (float)(tok & 63) * inv;
            const float sr = __sinf(ar), cr = __cosf(ar), sc = __sinf(ac), cc = __cosf(ac);
            const float a0 = x0, b0 = x1; x0 = a0 * cr - b0 * sr; x1 = b0 * cr + a0 * sr;
            const float a1 = x2, b1 = x3; x2 = a1 * cc - b1 * sc; x3 = b1 * cc + a1 * sc;
        }
        p[0] = (bf16_t)f2bf(x0 * outscale); p[16] = (bf16_t)f2bf(x1 * outscale); p[32] = (bf16_t)f2bf(x2 * outscale); p[48] = (bf16_t)f2bf(x3 * outscale);
    }
}
__device__ __forceinline__ void prep_vt(const bf16_t* PB, int tok0, int col, bf16_t* VT, LAS unsigned char* scr, int lane) {
    const bf16_t* p = PB + (size_t)(tok0 + lane) * INW + col;
    LAS unsigned* s32 = (LAS unsigned*)scr;
#pragma unroll
    for (int c = 0; c < 8; ++c) { const u32x4 w = *(const u32x4*)(p + 8 * c);
        s32[lane * 33 + 4 * c + 0] = w.x; s32[lane * 33 + 4 * c + 1] = w.y; s32[lane * 33 + 4 * c + 2] = w.z; s32[lane * 33 + 4 * c + 3] = w.w; }
    asm volatile("s_waitcnt lgkmcnt(0)" ::: "memory");
    const LAS bf16_t* s16 = (const LAS bf16_t*)scr;
    bf16_t* o = VT + (size_t)lane * NTOK + tok0;
#pragma unroll
    for (int c = 0; c < 8; ++c) { u32x4 w; unsigned t[8];
#pragma unroll
        for (int e = 0; e < 8; ++e) t[e] = s16[(8 * c + e) * 66 + lane];
        w.x = t[0] | (t[1] << 16); w.y = t[2] | (t[3] << 16); w.z = t[4] | (t[5] << 16); w.w = t[6] | (t[7] << 16);
        *(u32x4*)(o + 8 * c) = w; }
    asm volatile("s_waitcnt lgkmcnt(0)" ::: "memory");
}
__device__ __forceinline__ float lb_val(const float* logits, int l, int dir, int ch) {
    float v[4]; float mx = -3.0e38f;
#pragma unroll
    for (int j = 0; j < 4; ++j) { v[j] = logits[(j * 2 + dir) * 256 + ch]; mx = fmaxf(mx, v[j]); }
    float s = 0.f, c = 0.f;
#pragma unroll
    for (int j = 0; j < 4; ++j) { v[j] = expf(v[j] - mx); s += v[j]; if (j >= 1 && j <= l) c += v[j]; }
    return c / s;
}
__device__ __forceinline__ int hg_row(int dir, int c, int s) {
    const int p = 64 * c + s;
    if (dir == 0) return p < CTX ? SEQ + p : p - CTX;
    return p < CTX ? SEQ + (CTX - 1) - p : (SEQ - 1) - (p - CTX);
}
__device__ __forceinline__ void hgrn_h1_item(const Ctx& F, const bf16_t* PB, const float* logits, int l, int item, float* GS, float* HA, LAS unsigned char* scrb) {
    const int head = item & 3, c = (item >> 2) % NCHUNK, dir = item / (4 * NCHUNK), lane = F.lane, q_ = lane & 31, h = lane >> 5;
    constexpr int TP = 144;
    LAS unsigned char* TKh = scrb;
    const int colf = (dir ? C_BFB : C_BFF) + head * 64 + lane;
    const float lb = lb_val(logits, l, dir, head * 64 + lane);
    float r = 0.f;
#pragma unroll
    for (int cb = 7; cb >= 0; --cb) {
        float kh[8];
#pragma unroll
        for (int i = 7; i >= 0; --i) {
            const float pre = bf2f(PB[(size_t)hg_row(dir, c, 8 * cb + i) * INW + colf]);
            const float f = lb + (1.0f - lb) * sigmoidf_(pre);
            kh[i] = (1.0f - f) * __expf(r);
            r += __logf(f);
        }
        const u32x4 w = {pk2(kh[0], kh[1]), pk2(kh[2], kh[3]), pk2(kh[4], kh[5]), pk2(kh[6], kh[7])};
        *(LAS u32x4*)(TKh + lane * TP + 16 * cb) = w;
    }
    HA[(size_t)((dir * NCHUNK + c) * 4 + head) * 64 + lane] = __expf(r);
    asm volatile("s_waitcnt lgkmcnt(0)" ::: "memory");
    __builtin_amdgcn_wave_barrier();
    f32x16 g[2][2];
#pragma unroll
    for (int r2 = 0; r2 < 16; ++r2) { g[0][0][r2] = 0.f; g[0][1][r2] = 0.f; g[1][0][r2] = 0.f; g[1][1][r2] = 0.f; }
    const bf16_t* vbase = PB + C_BI + head * 64 + q_;
#pragma unroll
    for (int k = 0; k < 4; ++k) {
        const bf16x8 ka0 = *(const LAS bf16x8*)(TKh + q_ * TP + (16 * k + 8 * h) * 2), ka1 = *(const LAS bf16x8*)(TKh + (32 + q_) * TP + (16 * k + 8 * h) * 2);
#pragma unroll
        for (int vb = 0; vb < 2; ++vb) {
            unsigned e[8];
#pragma unroll
            for (int j = 0; j < 8; ++j) e[j] = vbase[(size_t)hg_row(dir, c, 16 * k + 8 * h + j) * INW + 32 * vb];
            const u32x4 w = {e[0] | (e[1] << 16), e[2] | (e[3] << 16), e[4] | (e[5] << 16), e[6] | (e[7] << 16)};
            const bf16x8 vf = __builtin_bit_cast(bf16x8, w);
            g[0][vb] = __builtin_amdgcn_mfma_f32_32x32x16_bf16(ka0, vf, g[0][vb], 0, 0, 0);
            g[1][vb] = __builtin_amdgcn_mfma_f32_32x32x16_bf16(ka1, vf, g[1][vb], 0, 0, 0);
        }
    }
    float* go = GS + ((size_t)((dir * NCHUNK + c) * 4 + head)) * 4096;
#pragma unroll
    for (int db = 0; db < 2; ++db)
#pragma unroll
        for (int vb = 0; vb < 2; ++vb)
#pragma unroll
            for (int r2 = 0; r2 < 16; ++r2) go[(32 * db + 8 * (r2 >> 2) + 4 * h + (r2 & 3)) * 64 + 32 * vb + q_] = g[db][vb][r2];
    asm volatile("s_waitcnt lgkmcnt(0)" ::: "memory");
    __builtin_amdgcn_wave_barrier();
}
__device__ __forceinline__ void pool_item(const Ctx& F, const bf16_t* PB, const float* wg  , const float* cscale  , bf16_t* Y, int item, LAS unsigned char* scrb) {
    const int g = item & 3, tile = item >> 2, lane = F.lane, q_ = lane & 31, h = lane >> 5;
    const int row0 = tile * 64, sb = row0 >= SEQ ? SEQ : 0, T = row0 >= SEQ ? CTX : SEQ, t0 = row0 - sb;
    const int half = 1 << g;
    LAS bf16_t* xs = (LAS bf16_t*)scrb;
    LAS unsigned char* PT = scrb + 10240;
    const bf16_t* xp = PB + (size_t)sb * INW + C_CX + 64 * g + lane;
#pragma clang loop vectorize(disable) interleave(disable) unroll_count(8)
    for (int i = 0; i < 80; ++i) { const int uc = min(max(t0 - 8 + i, 0), T - 1); xs[i * 64 + lane] = xp[(size_t)uc * INW]; }
    asm volatile("s_waitcnt lgkmcnt(0)" ::: "memory");
    float s = 0.f; int cnt = 0;
#pragma unroll
    for (int k = 0; k < 16; ++k) { const int dk = k - 8, u = t0 + dk; const bool ok = (dk >= -half) && (dk < half) && (u >= 0) && (u < T);
        const float xv = bf2f(xs[(8 + dk) * 64 + lane]); s += ok ? xv : 0.f; cnt += ok ? 1 : 0; }
#pragma unroll 4
    for (int tt = 0; tt < 64; ++tt) {
        if (tt > 0) { const int t = t0 + tt;
            if (t - 1 + half < T) { s += bf2f(xs[(tt + 7 + half) * 64 + lane]); ++cnt; }
            if (t - 1 - half >= 0) { s -= bf2f(xs[(tt + 7 - half) * 64 + lane]); --cnt; } }
        const float pooled = s * __builtin_amdgcn_rcpf((float)cnt) - bf2f(xs[(tt + 8) * 64 + lane]);
        *(LAS bf16_t*)(PT + tt * 128 + 2 * lane) = (bf16_t)f2bf(pooled);
    }
    asm volatile("s_waitcnt lgkmcnt(0)" ::: "memory");
    __builtin_amdgcn_wave_barrier();
    f32x16 acc[2][2];
#pragma unroll
    for (int r = 0; r < 16; ++r) { acc[0][0][r] = 0.f; acc[0][1][r] = 0.f; acc[1][0][r] = 0.f; acc[1][1][r] = 0.f; }
    const float* wp = wg + (size_t)g * 4096 + q_;
#pragma unroll
    for (int k = 0; k < 4; ++k) {
        const bf16x8 a0 = *(const LAS bf16x8*)(PT + q_ * 128 + (16 * k + 8 * h) * 2), a1 = *(const LAS bf16x8*)(PT + (32 + q_) * 128 + (16 * k + 8 * h) * 2);
#pragma unroll
        for (int vb = 0; vb < 2; ++vb) {
            float wv[8];
#pragma unroll
            for (int j = 0; j < 8; ++j) wv[j] = wp[(16 * k + 8 * h + j) * 64 + 32 * vb];
            const u32x4 w = {pk2(wv[0], wv[1]), pk2(wv[2], wv[3]), pk2(wv[4], wv[5]), pk2(wv[6], wv[7])};
            const bf16x8 wf = __builtin_bit_cast(bf16x8, w);
            acc[0][vb] = __builtin_amdgcn_mfma_f32_32x32x16_bf16(a0, wf, acc[0][vb], 0, 0, 0);
            acc[1][vb] = __builtin_amdgcn_mfma_f32_32x32x16_bf16(a1, wf, acc[1][vb], 0, 0, 0);
        }
    }
#pragma unroll
    for (int vb = 0; vb < 2; ++vb) {
        const float sc = cscale[64 * g + 32 * vb + q_];
#pragma unroll
        for (int tb = 0; tb < 2; ++tb)
#pragma unroll
            for (int r = 0; r < 16; ++r)
                Y[(size_t)(row0 + 32 * tb + 8 * (r >> 2) + 4 * h + (r & 3)) * D + 512 + 64 * g + 32 * vb + q_] = (bf16_t)f2bf(acc[tb][vb][r] * sc);
    }
    asm volatile("s_waitcnt lgkmcnt(0)" ::: "memory");
    __builtin_amdgcn_wave_barrier();
}

__device__ __forceinline__ void prep_h1_phase(LAS unsigned char* lds, unsigned char* ws, const float* logits, int l, int tid, int bid, int G) {
    Ctx F; F.lds = lds; F.tid = tid; F.lane = tid & 63; F.wave = __builtin_amdgcn_readfirstlane(tid >> 6); F.G = G; F.bid = bid; F.gw = bid * 8 + F.wave; F.ngw = G * 8;
    const bf16_t* PB = (const bf16_t*)(ws + WS_PB); float* GS = (float*)(ws + WS_XN); float* HA = (float*)(ws + WS_HA);
    LAS unsigned char* scr = F.lds + F.wave * 18432;
    for (int it = F.wave * F.G + F.bid; it < 2 * NCHUNK * 4; it += F.ngw) hgrn_h1_item(F, PB, logits, l, it, GS, HA, scr);
}
__device__ __forceinline__ void prep_pool_phase(const Ctx& F, const Args& a, int l) {
    unsigned char* ws = a.ws;
    const bf16_t* PB = (const bf16_t*)(ws + WS_PB); bf16_t* Y = (bf16_t*)(ws + WS_Y);
    LAS unsigned char* scr = F.lds + F.wave * 18432;
    for (int it = (7 - F.wave) * F.G + F.bid; it < NCHUNK * 4; it += F.ngw) pool_item(F, PB, in_ptr(16) + (size_t)l * 4 * 4096, in_ptr(17) + l * 256, Y, it, scr);
}
__device__ __forceinline__ void prep_qkv_phase(const Ctx& F, const Args& a, int l, int rep) {
    unsigned char* ws = a.ws;
    bf16_t* PB = (bf16_t*)(ws + WS_PB);
    bf16_t* VTA = (bf16_t*)(ws + WS_VTA); bf16_t* VTD = (bf16_t*)(ws + WS_VTD);
    LAS unsigned char* scr = F.lds + F.wave * 18432;
    const int nq = 4 * F.G, sl = (F.wave & 3) * F.G + F.bid;
    const int it_first = F.wave < 4 ? sl : 2 * nq + sl, it_step = F.wave < 4 ? nq : nq, it_end = F.wave < 4 ? 2 * nq : NCHUNK * 12;
    for (int it = it_first; it < it_end && it < NCHUNK * 12; it += it_step) {
        const int tile = it / 12, slot = it % 12, tok0 = tile * 64;
        int ln = F.lane; asm volatile("" : "+v"(ln));
        if (slot < 6 && rep > 0) continue;
        if (slot < 4) prep_qk(PB, tok0, C_AQ + 64 * slot, in_ptr(12) + l * 64, tok0 < SEQ, ATT_SCALE * LOG2E, ln);
        else if (slot < 6) prep_qk(PB, tok0, C_AK + 64 * (slot - 4), in_ptr(13) + l * 64, tok0 < SEQ, 1.0f, ln);
        else if (slot < 8) prep_vt(PB, tok0, C_AV + 64 * (slot - 6), VTA + (size_t)(slot - 6) * 64 * NTOK, scr, ln);
        else prep_vt(PB, tok0, C_DV + 64 * (slot - 8), VTD + (size_t)(slot - 8) * 64 * NTOK, scr, ln);
    }
}

template <bool NA>
__device__ __forceinline__ void attn_unit(LAS unsigned char* lds, const bf16_t* __restrict__ PB, const bf16_t* __restrict__ VT, bf16_t* __restrict__ Y,
                                          int q_tok0, int qcol, int kcol, int ycol, int ntiles, int loc_base, float qs,
                                          int na_r, int na_rs_base, int na_qc0, const float* relb, const int tid) {
    const int lane = tid & 63, q = lane & 31, h = lane >> 5;
    constexpr int KB = 9216, VB = 9216, VOFF = 2 * KB, BOFF = VOFF + 2 * VB;
    LAS float* biasL = (LAS float*)(lds + BOFF);
    bf16x8 qb[4];
    { const bf16_t* qp = PB + (size_t)(q_tok0 + q) * INW + qcol + 8 * h;
#pragma unroll
      for (int s = 0; s < 4; ++s) qb[s] = *(const bf16x8*)(qp + 16 * s); }
    __syncthreads();
    if (NA) { for (int i = tid; i < 465; i += 512) biasL[i] = relb[i] * LOG2E; }
    f32x16 o0, o1, negm;
#pragma unroll
    for (int r = 0; r < 16; ++r) { o0[r] = 0.f; o1[r] = 0.f; negm[r] = 0.f; }
    float m = 0.f, l = 0.f;
    const int srow = tid >> 3, sch = tid & 7;
    u32x4 kreg, vreg;
    { const int t0 = SEQ;
      kreg = *(const u32x4*)(PB + (size_t)(t0 + srow) * INW + kcol + 8 * sch); vreg = *(const u32x4*)(VT + (size_t)srow * NTOK + t0 + 8 * sch); }
    *(LAS u32x4*)(lds + srow * 144 + sch * 16) = kreg;
    { LAS unsigned char* vp = lds + VOFF + srow * 144 + (sch >> 1) * 32 + (sch & 1) * 8;
      *(LAS u32x2*)vp = (u32x2){vreg.x, vreg.y}; *(LAS u32x2*)(vp + 16) = (u32x2){vreg.z, vreg.w}; }
    __syncthreads();
    const int na_cs = NA ? min(max(na_qc0 + q - 8, 0), 48) : 0;
    const int na_rs = NA ? min(max(na_r - 4, 0), 248) : 0;
    for (int j = 0; j < ntiles; ++j) {
        const int cur = j & 1;
        if (j + 1 < ntiles) { const int t0 = (j + 1) < 4 ? SEQ + 64 * (j + 1) : loc_base + 64 * (j + 1 - 4);
            kreg = *(const u32x4*)(PB + (size_t)(t0 + srow) * INW + kcol + 8 * sch); vreg = *(const u32x4*)(VT + (size_t)srow * NTOK + t0 + 8 * sch); }
        bool active = true; int kr = 0;
        if (NA && j >= 4) { kr = na_rs_base + (j - 4); active = (kr >= na_rs) && (kr < na_rs + 8); }
        if (active) {
            const LAS unsigned char* kb = lds + cur * KB; const LAS unsigned char* vb = lds + VOFF + cur * VB;
            f32x16 p0, p1;
            if (NA) {
#pragma unroll
                for (int r = 0; r < 16; ++r) { p0[r] = 0.f; p1[r] = 0.f; }
            } else { p0 = negm; p1 = negm; }
            bf16x8 kf[8], vfr[8];
#pragma unroll
            for (int s = 0; s < 4; ++s) {
                kf[2 * s] = *(const LAS bf16x8*)(kb + q * 144 + (16 * s + 8 * h) * 2);
                kf[2 * s + 1] = *(const LAS bf16x8*)(kb + (q + 32) * 144 + (16 * s + 8 * h) * 2);
            }
#pragma unroll
            for (int s = 0; s < 4; ++s) {
                vfr[2 * s] = *(const LAS bf16x8*)(vb + q * 144 + 32 * s + 16 * h);
                vfr[2 * s + 1] = *(const LAS bf16x8*)(vb + (q + 32) * 144 + 32 * s + 16 * h);
            }
            __builtin_amdgcn_sched_barrier(0);
            __builtin_amdgcn_s_setprio(1);
#pragma unroll
            for (int s = 0; s < 4; ++s) {
                p0 = __builtin_amdgcn_mfma_f32_32x32x16_bf16(kf[2 * s], qb[s], p0, 0, 0, 0);
                p1 = __builtin_amdgcn_mfma_f32_32x32x16_bf16(kf[2 * s + 1], qb[s], p1, 0, 0, 0);
            }
            __builtin_amdgcn_s_setprio(0);
            if (NA) {
                if (j >= 4) {
                    const int dr = kr - na_r + 7, qc = na_qc0 + q;
#pragma unroll
                    for (int r = 0; r < 16; ++r) {
                        const int kc = 8 * (r >> 2) + 4 * h + (r & 3);
                        const bool v0 = (kc >= na_cs) && (kc < na_cs + 16), v1 = (kc + 32 >= na_cs) && (kc + 32 < na_cs + 16);
                        const int i0 = v0 ? dr * 31 + (kc - qc + 15) : 0, i1 = v1 ? dr * 31 + (kc + 32 - qc + 15) : 0;
                        const float b0 = biasL[i0], b1 = biasL[i1];
                        p0[r] = v0 ? p0[r] * qs + b0 - m : -INFINITY; p1[r] = v1 ? p1[r] * qs + b1 - m : -INFINITY;
                    }
                } else {
#pragma unroll
                    for (int r = 0; r < 16; ++r) { p0[r] = p0[r] * qs - m; p1[r] = p1[r] * qs - m; }
                }
            }
            float mx = fmaxf(fmaxf(p0[0], p1[0]), p0[1]), mx2 = fmaxf(fmaxf(p1[1], p0[2]), p1[2]);
#pragma unroll
            for (int r = 3; r < 15; r += 3) { mx = fmaxf(fmaxf(mx, p0[r]), p1[r]); mx2 = fmaxf(fmaxf(mx2, p0[r + 1]), p1[r + 1]); mx = fmaxf(fmaxf(mx, p0[r + 2]), p1[r + 2]); }
            mx = fmaxf(fmaxf(mx, mx2), fmaxf(p0[15], p1[15]));
            mx = xor32_max(mx);
            const bool need = (mx > 0.f) || (j == 0);
            if (__builtin_amdgcn_ballot_w64(need) != 0ull) {
                const float delta = need ? mx : 0.f;
                const float alpha = __builtin_amdgcn_exp2f(-delta);
                m += delta; l *= alpha;
#pragma unroll
                for (int r = 0; r < 16; ++r) { o0[r] *= alpha; o1[r] *= alpha; p0[r] -= delta; p1[r] -= delta; negm[r] = -m; }
            }
            float ls = 0.f;
#pragma unroll
            for (int r = 0; r < 16; ++r) { p0[r] = __builtin_amdgcn_exp2f(p0[r]); p1[r] = __builtin_amdgcn_exp2f(p1[r]); ls += p0[r] + p1[r]; }
            l += ls;
            bf16x8 pb[4];
            { u32x4 w;
              w.x = pk2(p0[0], p0[1]); w.y = pk2(p0[2], p0[3]); w.z = pk2(p0[4], p0[5]); w.w = pk2(p0[6], p0[7]); pb[0] = __builtin_bit_cast(bf16x8, w);
              w.x = pk2(p0[8], p0[9]); w.y = pk2(p0[10], p0[11]); w.z = pk2(p0[12], p0[13]); w.w = pk2(p0[14], p0[15]); pb[1] = __builtin_bit_cast(bf16x8, w);
              w.x = pk2(p1[0], p1[1]); w.y = pk2(p1[2], p1[3]); w.z = pk2(p1[4], p1[5]); w.w = pk2(p1[6], p1[7]); pb[2] = __builtin_bit_cast(bf16x8, w);
              w.x = pk2(p1[8], p1[9]); w.y = pk2(p1[10], p1[11]); w.z = pk2(p1[12], p1[13]); w.w = pk2(p1[14], p1[15]); pb[3] = __builtin_bit_cast(bf16x8, w); }
#pragma unroll
            for (int s = 0; s < 4; ++s) {
                const bf16x8 vf0 = vfr[2 * s], vf1 = vfr[2 * s + 1];
                o0 = __builtin_amdgcn_mfma_f32_32x32x16_bf16(vf0, pb[s], o0, 0, 0, 0);
                o1 = __builtin_amdgcn_mfma_f32_32x32x16_bf16(vf1, pb[s], o1, 0, 0, 0);
            }
        }
        if (j + 1 < ntiles) {
            *(LAS u32x4*)(lds + (cur ^ 1) * KB + srow * 144 + sch * 16) = kreg;
            LAS unsigned char* vp = lds + VOFF + (cur ^ 1) * VB + srow * 144 + (sch >> 1) * 32 + (sch & 1) * 8;
            *(LAS u32x2*)vp = (u32x2){vreg.x, vreg.y}; *(LAS u32x2*)(vp + 16) = (u32x2){vreg.z, vreg.w};
        }
        __syncthreads();
    }
    const float lt = xor32_sum(l), inv = 1.0f / lt;
    bf16_t* yp = Y + (size_t)(q_tok0 + q) * D + ycol + 4 * h;
#pragma unroll
    for (int g4 = 0; g4 < 4; ++g4) {
        u32x2 w0, w1;
        w0.x = pk2(o0[4 * g4] * inv, o0[4 * g4 + 1] * inv); w0.y = pk2(o0[4 * g4 + 2] * inv, o0[4 * g4 + 3] * inv);
        w1.x = pk2(o1[4 * g4] * inv, o1[4 * g4 + 1] * inv); w1.y = pk2(o1[4 * g4 + 2] * inv, o1[4 * g4 + 3] * inv);
        *(u32x2*)(yp + 8 * g4) = w0; *(u32x2*)(yp + 32 + 8 * g4) = w1;
    }
}

__device__ __forceinline__ void small_attn_phase(const Ctx& F, const Args& a, int l, int rep) {
    unsigned char* ws = a.ws;
    bf16_t* PB = (bf16_t*)(ws + WS_PB); bf16_t* Y = (bf16_t*)(ws + WS_Y);
    const bf16_t* VTA = (const bf16_t*)(ws + WS_VTA); const bf16_t* VTD = (const bf16_t*)(ws + WS_VTD);
    float* GS = (float*)(ws + WS_XN); const float* HA = (const float*)(ws + WS_HA);
    const int w = F.wave;
    const int nscan = F.G >= 128 ? 64 : 0;
    const int nwork = F.G - nscan;
    for (int it = (nscan ? F.bid - nwork : F.bid); rep == 0 && it >= 0 && it < 64; it += (nscan ? 64 : F.G)) {
        const int dh = it >> 3, dblk = it & 7, d = dblk * 8 + (F.tid >> 6), v = F.tid & 63;
        float S = 0.f;
        for (int c0 = 0; c0 < NCHUNK; c0 += 20) {
            float gq[20], aq[20];
#pragma unroll
            for (int j = 0; j < 20; ++j) { const size_t u = (size_t)((dh >> 2) * NCHUNK + c0 + j) * 4 + (dh & 3); gq[j] = GS[u * 4096 + d * 64 + v]; aq[j] = HA[u * 64 + d]; }
#pragma unroll
            for (int j = 0; j < 20; ++j) { const size_t u = (size_t)((dh >> 2) * NCHUNK + c0 + j) * 4 + (dh & 3); GS[u * 4096 + d * 64 + v] = S; S = aq[j] * S + gq[j]; }
        }
    }
    if (nscan && F.bid >= nwork) return;
    for (int u = F.bid; u < 256 + 8; u += nwork) {
        if (u < 256) {
            const int head = u & 3, rg = u >> 2, r = 4 * rg + (w >> 1);
            const int rs0 = min(max(4 * rg - 4, 0), 248), rs3 = min(max(4 * rg + 3 - 4, 0), 248);
            attn_unit<true>(F.lds, PB, VTD + (size_t)head * 64 * NTOK, Y, 64 * r + 32 * (w & 1), C_DQ + 64 * head, C_DK + 64 * head, 768 + 64 * head, 4 + (rs3 + 8 - rs0), 64 * rs0,
                            ATT_SCALE * LOG2E, r, rs0, 32 * (w & 1), in_ptr(18) + ((size_t)l * 4 + head) * 465, F.tid);
        } else if (u < 260) { const int uu = u - 256, kvh = uu & 1, t128 = uu >> 1, hq = 2 * kvh + (w >> 2);
            attn_unit<false>(F.lds, PB, VTA + (size_t)kvh * 64 * NTOK, Y, SEQ + t128 * 128 + 32 * (w & 3), C_AQ + 64 * hq, C_AK + 64 * kvh, 64 * hq, 4, 0, 1.0f, 0, 0, 0, nullptr, F.tid);
        } else { const int head = u - 260;
            attn_unit<true>(F.lds, PB, VTD + (size_t)head * 64 * NTOK, Y, SEQ + 32 * w, C_DQ + 64 * head, C_DK + 64 * head, 768 + 64 * head, 4, 0, ATT_SCALE * LOG2E, 0, 0, 0, in_ptr(18) + ((size_t)l * 4 + head) * 465, F.tid);
        }
    }
}
__device__ __forceinline__ void attn_phase(const Ctx& F, const Args& a, int l) {
    unsigned char* ws = a.ws;
    bf16_t* PB = (bf16_t*)(ws + WS_PB); bf16_t* Y = (bf16_t*)(ws + WS_Y);
    const bf16_t* VTA = (const bf16_t*)(ws + WS_VTA);
    const int w = F.wave;
    for (int u = F.bid; u < 256; u += F.G) {
        const int kvh = u & 1, t128 = u >> 1, hq = 2 * kvh + (w >> 2);
        attn_unit<false>(F.lds, PB, VTA + (size_t)kvh * 64 * NTOK, Y, t128 * 128 + 32 * (w & 3), C_AQ + 64 * hq, C_AK + 64 * kvh, 64 * hq, 4 + SEQ / 64, 0, 1.0f, 0, 0, 0, nullptr, F.tid);
    }
}

__device__ __forceinline__ void sum4_phase(const Ctx& F, const bf16_t* PB, bf16_t* MG) {
    for (int i = F.bid * 512 + F.tid; i < NTOK * 128; i += F.G * 512) {
        const int row = i >> 7, c8 = (i & 127) * 8;
        const bf16_t* zp = PB + (size_t)row * INW + C_GATE + c8;
        const u32x4 a = *(const u32x4*)zp, b = *(const u32x4*)(zp + 1024), c = *(const u32x4*)(zp + 2048), d = *(const u32x4*)(zp + 3072);
        u32x4 o;
        o.x = pk2((lo16(a.x) + lo16(b.x)) + (lo16(c.x) + lo16(d.x)), (hi16(a.x) + hi16(b.x)) + (hi16(c.x) + hi16(d.x)));
        o.y = pk2((lo16(a.y) + lo16(b.y)) + (lo16(c.y) + lo16(d.y)), (hi16(a.y) + hi16(b.y)) + (hi16(c.y) + hi16(d.y)));
        o.z = pk2((lo16(a.z) + lo16(b.z)) + (lo16(c.z) + lo16(d.z)), (hi16(a.z) + hi16(b.z)) + (hi16(c.z) + hi16(d.z)));
        o.w = pk2((lo16(a.w) + lo16(b.w)) + (lo16(c.w) + lo16(d.w)), (hi16(a.w) + hi16(b.w)) + (hi16(c.w) + hi16(d.w)));
        *(u32x4*)(MG + (size_t)row * D + c8) = o;
    }
}

__device__ __forceinline__ void hgrn_out_phase(const Ctx& F, const Args& a, int l) {
    unsigned char* ws = a.ws;
    const bf16_t* PB = (const bf16_t*)(ws + WS_PB); bf16_t* Y = (bf16_t*)(ws + WS_Y);
    const float* GS = (const float*)(ws + WS_XN);
    constexpr int WREG = 18432, TP = 144;
    const int lane = F.lane, dir = F.wave >> 2, wi = F.wave & 3, q_ = lane & 31, h = lane >> 5;
    LAS unsigned char* TQ = F.lds + F.wave * WREG;
    LAS unsigned char* TK = TQ + 9216;
    LAS float* ob = (LAS float*)TQ;
    const LAS float* ob_f = (const LAS float*)(F.lds + wi * WREG);
    const LAS float* ob_b = (const LAS float*)(F.lds + (wi + 4) * WREG);
    const float og = in_ptr(15)[l * 64 + lane];
    for (int it0 = 4 * F.bid; it0 < NCHUNK * 4; it0 += 4 * F.G) {
        const int it = it0 + wi;
        const int head = it & 3, jc = it >> 2;
        const int rb = jc < 256 ? 64 * jc : SEQ + 64 * (jc - 256);
        {
            const int c = dir == 0 ? (jc < 256 ? 4 + jc : jc - 256) : (jc < 256 ? 4 + 255 - jc : 3 - (jc - 256));
            const float lb = lb_val(in_ptr(14), l, dir, head * 64 + lane);
            const int colf = (dir ? C_BFB : C_BFF) + head * 64 + lane, colq = C_BQ + head * 64 + lane;
            float fv[64]; float ref = 0.f;
#pragma unroll
            for (int t = 0; t < 64; ++t) {
                const float pre = bf2f(PB[(size_t)(rb + (dir ? 63 - t : t)) * INW + colf]);
                const float f = lb + (1.0f - lb) * sigmoidf_(pre);
                fv[t] = f;
                if (t < 32) ref += __logf(f);
            }
            unsigned qh[32]; float cum = 0.f, qh_prev = 0.f;
#pragma unroll
            for (int t = 0; t < 64; ++t) {
                const float qv = bf2f(PB[(size_t)(rb + (dir ? 63 - t : t)) * INW + colq]) * 0.125f;
                cum += __logf(fv[t]);
                const float qt = qv * __expf(fminf(cum - ref, 80.f));
                const float kt = (1.0f - fv[t]) * __expf(fminf(ref - cum, 80.f));
                const float qhv = qv * __expf(cum);
                *(LAS bf16_t*)(TQ + t * TP + 2 * lane) = (bf16_t)f2bf(qt);
                *(LAS bf16_t*)(TK + t * TP + 2 * lane) = (bf16_t)f2bf(kt);
                if (t & 1) qh[t >> 1] = pk2(qh_prev, qhv); else qh_prev = qhv;
            }
            asm volatile("s_waitcnt lgkmcnt(0)" ::: "memory");
            __builtin_amdgcn_wave_barrier();
            f32x16 a00, a01, a11;
#pragma unroll
            for (int r = 0; r < 16; ++r) { a00[r] = 0.f; a01[r] = 0.f; a11[r] = 0.f; }
#pragma unroll
            for (int k = 0; k < 4; ++k) {
                const bf16x8 ka0 = *(const LAS bf16x8*)(TK + q_ * TP + (16 * k + 8 * h) * 2), ka1 = *(const LAS bf16x8*)(TK + (32 + q_) * TP + (16 * k + 8 * h) * 2);
                const bf16x8 qb0 = *(const LAS bf16x8*)(TQ + q_ * TP + (16 * k + 8 * h) * 2), qb1 = *(const LAS bf16x8*)(TQ + (32 + q_) * TP + (16 * k + 8 * h) * 2);
                a00 = __builtin_amdgcn_mfma_f32_32x32x16_bf16(ka0, qb0, a00, 0, 0, 0);
                a01 = __builtin_amdgcn_mfma_f32_32x32x16_bf16(ka0, qb1, a01, 0, 0, 0);
                a11 = __builtin_amdgcn_mfma_f32_32x32x16_bf16(ka1, qb1, a11, 0, 0, 0);
            }
#pragma unroll
            for (int r = 0; r < 16; ++r) { const bool ok = (8 * (r >> 2) + 4 * h + (r & 3)) <= q_; a00[r] = ok ? a00[r] : 0.f; a11[r] = ok ? a11[r] : 0.f; }
            bf16x8 p00[2], p01[2], p11[2];
#pragma unroll
            for (int k = 0; k < 2; ++k) { u32x4 w;
                w.x = pk2(a00[8 * k], a00[8 * k + 1]); w.y = pk2(a00[8 * k + 2], a00[8 * k + 3]); w.z = pk2(a00[8 * k + 4], a00[8 * k + 5]); w.w = pk2(a00[8 * k + 6], a00[8 * k + 7]); p00[k] = __builtin_bit_cast(bf16x8, w);
                w.x = pk2(a01[8 * k], a01[8 * k + 1]); w.y = pk2(a01[8 * k + 2], a01[8 * k + 3]); w.z = pk2(a01[8 * k + 4], a01[8 * k + 5]); w.w = pk2(a01[8 * k + 6], a01[8 * k + 7]); p01[k] = __builtin_bit_cast(bf16x8, w);
                w.x = pk2(a11[8 * k], a11[8 * k + 1]); w.y = pk2(a11[8 * k + 2], a11[8 * k + 3]); w.z = pk2(a11[8 * k + 4], a11[8 * k + 5]); w.w = pk2(a11[8 * k + 6], a11[8 * k + 7]); p11[k] = __builtin_bit_cast(bf16x8, w); }
            asm volatile("s_waitcnt lgkmcnt(0)" ::: "memory");
            __builtin_amdgcn_wave_barrier();
#pragma unroll
            for (int t2 = 0; t2 < 32; ++t2) { *(LAS bf16_t*)(TQ + (2 * t2) * TP + 2 * lane) = (bf16_t)(qh[t2] & 0xffffu); *(LAS bf16_t*)(TQ + (2 * t2 + 1) * TP + 2 * lane) = (bf16_t)(qh[t2] >> 16); }
            f32x16 o[2][2];
#pragma unroll
            for (int r = 0; r < 16; ++r) { o[0][0][r] = 0.f; o[0][1][r] = 0.f; o[1][0][r] = 0.f; o[1][1][r] = 0.f; }
            const bf16_t* vbase = PB + C_BI + head * 64 + q_;
#pragma unroll
            for (int cv = 0; cv < 2; ++cv)
#pragma unroll
                for (int sa = 0; sa < 2; ++sa)
#pragma unroll
                    for (int k = 0; k < 2; ++k) {
                        unsigned e[8];
#pragma unroll
                        for (int j = 0; j < 8; ++j) { const int s = 32 * sa + 16 * k + 8 * (j >> 2) + 4 * h + (j & 3); e[j] = vbase[(size_t)(rb + (dir ? 63 - s : s)) * INW + 32 * cv]; }
                        const u32x4 w = {e[0] | (e[1] << 16), e[2] | (e[3] << 16), e[4] | (e[5] << 16), e[6] | (e[7] << 16)};
                        const bf16x8 vf = __builtin_bit_cast(bf16x8, w);
                        if (sa == 0) { o[cv][0] = __builtin_amdgcn_mfma_f32_32x32x16_bf16(vf, p00[k], o[cv][0], 0, 0, 0); o[cv][1] = __builtin_amdgcn_mfma_f32_32x32x16_bf16(vf, p01[k], o[cv][1], 0, 0, 0); }
                        else o[cv][1] = __builtin_amdgcn_mfma_f32_32x32x16_bf16(vf, p11[k], o[cv][1], 0, 0, 0);
                    }
            asm volatile("s_waitcnt lgkmcnt(0)" ::: "memory");
            __builtin_amdgcn_wave_barrier();
            const float* sbase = GS + ((size_t)((dir * NCHUNK + c) * 4 + head)) * 4096 + q_;
#pragma unroll
            for (int cv = 0; cv < 2; ++cv)
#pragma unroll
                for (int k = 0; k < 4; ++k) {
                    float sv[8];
#pragma unroll
                    for (int j = 0; j < 8; ++j) sv[j] = sbase[(16 * k + 8 * h + j) * 64 + 32 * cv];
                    const u32x4 w = {pk2(sv[0], sv[1]), pk2(sv[2], sv[3]), pk2(sv[4], sv[5]), pk2(sv[6], sv[7])};
                    const bf16x8 sf = __builtin_bit_cast(bf16x8, w);
                    const bf16x8 qb0 = *(const LAS bf16x8*)(TQ + q_ * TP + (16 * k + 8 * h) * 2), qb1 = *(const LAS bf16x8*)(TQ + (32 + q_) * TP + (16 * k + 8 * h) * 2);
                    o[cv][0] = __builtin_amdgcn_mfma_f32_32x32x16_bf16(sf, qb0, o[cv][0], 0, 0, 0);
                    o[cv][1] = __builtin_amdgcn_mfma_f32_32x32x16_bf16(sf, qb1, o[cv][1], 0, 0, 0);
                }
            asm volatile("s_waitcnt lgkmcnt(0)" ::: "memory");
            __builtin_amdgcn_wave_barrier();
#pragma unroll
            for (int cv = 0; cv < 2; ++cv)
#pragma unroll
                for (int tb = 0; tb < 2; ++tb) {
                    const int t = 32 * tb + q_, tt = dir ? 63 - t : t;
#pragma unroll
                    for (int g4 = 0; g4 < 4; ++g4)
                        *(LAS f32x4*)(ob + tt * 64 + 32 * cv + 8 * g4 + 4 * h) = (f32x4){o[cv][tb][4 * g4], o[cv][tb][4 * g4 + 1], o[cv][tb][4 * g4 + 2], o[cv][tb][4 * g4 + 3]};
                }
        }
        __syncthreads();
        {
#pragma unroll 4
            for (int k = 0; k < 32; ++k) {
                const int tt = 32 * dir + k;
                const float ot = ob_f[tt * 64 + lane] + ob_b[tt * 64 + lane];
                const float ss = wave_sum(ot * ot);
                const float gg = bf2f(PB[(size_t)(rb + tt) * INW + C_BG + head * 64 + lane]);
                const float y = ot * (1.0f / sqrtf(ss * (1.f / 64.f) + EPSN)) * og * siluf_(gg);
                Y[(size_t)(rb + tt) * D + 256 + head * 64 + lane] = (bf16_t)f2bf(y);
            }
        }
        __syncthreads();
    }
}

#define XB_TMO      128
#define XB_XCNT(j)  (256  + 64 * (j))
#define XB_XSUB(j)  (1280 + 64 * (j))
#define XB_XGEN(j)  (2304 + 64 * (j))
#define XB_TOP      3328
#define XB_TOPGEN   3392
#define XCD_BAR_WORDS 3456
#define XB_SPIN_CAP (1u << 18)

__device__ __forceinline__ unsigned xb_ld(unsigned* p)              { return __hip_atomic_load(p, __ATOMIC_RELAXED, __HIP_MEMORY_SCOPE_AGENT); }
__device__ __forceinline__ unsigned xb_add(unsigned* p, unsigned v) { return __hip_atomic_fetch_add(p, v, __ATOMIC_RELAXED, __HIP_MEMORY_SCOPE_AGENT); }
__device__ __forceinline__ unsigned xb_xcc_id() { return (unsigned)__builtin_amdgcn_s_getreg((3 << 11) | 20) & 0xFu; }
#define XB_SPIN(cond, bar) do { unsigned _sp = 0; while (cond) { __builtin_amdgcn_s_sleep(1); \
    if ((++_sp & 255u) == 0u) { if (xb_ld(&(bar)[XB_TMO])) break; if (_sp > XB_SPIN_CAP) { atomicAdd(&(bar)[XB_TMO], 1u); break; } } } } while (0)

struct XcdBarrier {
    unsigned* bar; unsigned x;
    volatile LAS unsigned* st;
};

__device__ __forceinline__ XcdBarrier xcd_barrier_post(unsigned* bar, volatile LAS unsigned* st) {
    XcdBarrier b; b.bar = bar; b.x = xb_xcc_id(); b.st = st;
    if (threadIdx.x == 0) (void)xb_add(&bar[XB_XCNT(b.x)], 1u);
    return b;
}
__device__ __forceinline__ void xcd_barrier_complete(unsigned* bar, unsigned x, unsigned& nloc, unsigned& nx) {
    const unsigned G = gridDim.x * gridDim.y * gridDim.z;
    unsigned sum, cnt, mine, sp = 0u;
    for (;;) {
        sum = 0u; cnt = 0u; mine = 0u;
#pragma unroll
        for (unsigned j = 0; j < 16; ++j) { const unsigned c = xb_ld(&bar[XB_XCNT(j)]); sum += c; cnt += (c > 0u) ? 1u : 0u; mine = (j == x) ? c : mine; }
        if (sum == G) break;
        __builtin_amdgcn_s_sleep(1);
        if ((++sp & 255u) == 0u) { if (xb_ld(&bar[XB_TMO])) break; if (sp > XB_SPIN_CAP) { atomicAdd(&bar[XB_TMO], 1u); break; } }
    }
    nloc = mine > 0u ? mine : 1u; nx = cnt > 0u ? cnt : 1u;
}

__device__ __forceinline__ void xcd_barrier(const XcdBarrier& b) {
    asm volatile("s_waitcnt vmcnt(0)" ::: "memory");
    __syncthreads();
    if (threadIdx.x == 0) {
        unsigned* bar = b.bar;
        __builtin_amdgcn_s_waitcnt(0);
        unsigned nloc = b.st[0], nx = b.st[1];
        if (nloc == 0u) { xcd_barrier_complete(bar, b.x, nloc, nx); b.st[0] = nloc; b.st[1] = nx; }
        const unsigned old = xb_add(&bar[XB_XSUB(b.x)], 1u);
        const unsigned gen = old / nloc;
        if (old + 1u == (gen + 1u) * nloc) {
            __builtin_amdgcn_fence(__ATOMIC_RELEASE, "agent");
            asm volatile("s_waitcnt vmcnt(0)" ::: "memory");
            const unsigned og = xb_add(&bar[XB_TOP], 1u);
            const unsigned tg = og / nx;
            if (og + 1u == (tg + 1u) * nx) xb_add(&bar[XB_TOPGEN], 1u);
            else XB_SPIN(xb_ld(&bar[XB_TOPGEN]) == tg, bar);
            __builtin_amdgcn_fence(__ATOMIC_ACQUIRE, "agent");
            xb_add(&bar[XB_XGEN(b.x)], 1u);
            asm volatile("s_waitcnt vmcnt(0)" ::: "memory");
        } else {
            XB_SPIN(xb_ld(&bar[XB_XGEN(b.x)]) == gen, bar);
            __builtin_amdgcn_fence(__ATOMIC_ACQUIRE, "agent");
            asm volatile("s_waitcnt vmcnt(0)" ::: "memory");
        }
    }
    __syncthreads();
}

__device__ __forceinline__ Ctx relaunder(Ctx F) {
    int t = F.tid; asm volatile("" : "+v"(t));
    F.tid = t; F.lane = t & 63; F.wave = __builtin_amdgcn_readfirstlane(t >> 6); F.gw = F.bid * 8 + F.wave;
    return F;
}
__global__ void __launch_bounds__(512, 2) mk_fwd(Args args) {
    extern __shared__ __attribute__((aligned(16))) unsigned char lds_raw[];
    cg::grid_group grid = cg::this_grid();
    unsigned char* ws = args.ws;
    float* X = (float*)(ws + WS_X); bf16_t* XN = (bf16_t*)(ws + WS_XN); bf16_t* PB = (bf16_t*)(ws + WS_PB); bf16_t* Y = (bf16_t*)(ws + WS_Y);
    const int wave0 = __builtin_amdgcn_readfirstlane(threadIdx.x >> 6);
    volatile LAS unsigned* bar_st = (volatile LAS unsigned*)((LAS unsigned char*)lds_raw + (LDS_BYTES - 256));
    if (threadIdx.x < 2) bar_st[threadIdx.x] = 0u;
    __syncthreads();
    const XcdBarrier xbar = xcd_barrier_post((unsigned*)args.ws, bar_st);
    for (int ph = args.ph_lo; ph < args.ph_hi; ++ph) {
        unsigned z_; asm volatile("v_mov_b32 %0, 0" : "=v"(z_));
        const int lane_ = (int)__builtin_amdgcn_mbcnt_hi(~0u, __builtin_amdgcn_mbcnt_lo(~0u, z_)); int bid_ = blockIdx.x;
        asm volatile("" : "+s"(bid_));
        const int tid_ = wave0 * 64 + lane_;
        Ctx F0;
        F0.lds = (LAS unsigned char*)lds_raw;
        F0.tid = tid_; F0.lane = F0.tid & 63; F0.wave = wave0;
        F0.G = gridDim.x; F0.bid = bid_; F0.gw = F0.bid * 8 + F0.wave; F0.ngw = F0.G * 8;
        int nrep = 1;
        if (PROBE_DBL) { const int sp_ = (ph - 1) % NSUB;
            if (ph == 0) nrep = (PROBE_DBL & 1) ? 2 : 1;
            else if (ph == NPHASE - 1) nrep = (PROBE_DBL & 64) ? 2 : 1;
            else if (sp_ == 0 || sp_ == 3 || sp_ == 11) nrep = (PROBE_DBL & 2) ? 2 : 1;
            else if (sp_ == 1 || sp_ == 12) nrep = (PROBE_DBL & 4) ? 2 : 1;
            else if (sp_ == 4) nrep = (PROBE_DBL & 8) ? 2 : 1;
            else if (sp_ == 2 || sp_ == 13) nrep = (PROBE_DBL & 1024) ? 2 : 1;
            else if (sp_ == 10) nrep = (PROBE_DBL & 2048) ? 2 : 1;
            else if (sp_ == 5) nrep = (PROBE_DBL & 256) ? 2 : 1;
            else if (sp_ == 6) nrep = (PROBE_DBL & 512) ? 2 : 1;
            else if (sp_ == 7) nrep = (PROBE_DBL & 16) ? 2 : 1;
            }
        for (int rep = 0; rep < nrep; ++rep) {
        if (ph == 0) { if (PHM & 1) { const Ctx F = relaunder(F0); phase0(F, args); } }
        else if (ph == NPHASE - 1) { if (PHM & 2) { const Ctx F = relaunder(F0); final_norm_phase(F, X, in_ptr(25), args.out); } }
        else {
            const int l = (ph - 1) / NSUB, sp = (ph - 1) % NSUB;
            const float* modl = (const float*)(ws + WS_MOD) + (size_t)l * 2 * NMODV;
            const bf16_t* WL = (const bf16_t*)(ws + WS_W) + (size_t)l * LAYER_W;
            if ((PHM & 4) && sp == 0) { const Ctx F = relaunder(F0); norm_phase(F, X, in_ptr(6) + l * D, modl, 0, 1, XN, (const float*)(ws + WS_PART), l > 0 ? 11 : 0); }
            else if ((PHM & 4) && sp == 3) { const Ctx F = relaunder(F0); norm_phase(F, X, in_ptr(10) + l * D, modl, 3, 4, XN, (const float*)(ws + WS_PART), 11); }
            else if ((PHM & 4) && sp == 11) { const Ctx F = relaunder(F0); norm_phase(F, X, in_ptr(21) + l * D, modl, 6, 7, XN, (const float*)(ws + WS_PART), 8); }
            else if ((PHM & 8) && (sp == 1 || sp == 12)) {
                const Ctx F = relaunder(F0);
                pg8::Gemm g{XN, WL + (sp == 1 ? O_WGU1 : O_WGU2), NTOK, 2 * DFF, D, D, 30, 0}; pg8::StaticOrder S; S.init(NTOK, 2 * DFF, D, F.G, F.bid);
                pg8::EpiSwiglu E{PB};
                pg8::gemm_phase<pg8::EpiSwiglu, pg8::StaticOrder>(F.lds, g, S, E, F.tid);
            } else if ((PHM & 16) && (sp == 2 || sp == 13)) {
                const Ctx F = relaunder(F0);
                pg8::Gemm g{PB, WL + (sp == 2 ? O_WD1 : O_WD2), NTOK, D, DFF, DFF, 30, 0}; pg8::ResidOrder S; S.init(DFF, 11, F.G, F.bid);
                pg8::EpiResid E{X, modl, sp == 2 ? 2 : 8, rep == 0 ? 0.5f : 0.0f, DFF / 64, (float*)(ws + WS_PART), 2};
                pg8::gemm_phase<pg8::EpiResid, pg8::ResidOrder>(F.lds, g, S, E, F.tid);
            } else if ((PHM & 32) && sp == 4) {
                const Ctx F = relaunder(F0);
                pg8::Gemm g{XN, WL + O_WIN, NTOK, INW, D, D, 30, 0}; pg8::StaticOrder S; S.init(NTOK, INW, D, F.G, F.bid);
                pg8::EpiPlain E{PB, INW};
                pg8::gemm_phase<pg8::EpiPlain, pg8::StaticOrder>(F.lds, g, S, E, F.tid);
            } else if ((PHM & 64) && sp == 5) { { const Ctx F = relaunder(F0); prep_h1_phase(F.lds, ws, in_ptr(14), l, F.tid, F.bid, F.G); } { const Ctx F = relaunder(F0); prep_pool_phase(F, args, l); } { const Ctx F = relaunder(F0); prep_qkv_phase(F, args, l, rep); } }
            else if ((PHM & 128) && sp == 6) { const Ctx F = relaunder(F0); small_attn_phase(F, args, l, rep); }
            else if ((PHM & 128) && sp == 7) {
                { const Ctx F = relaunder(F0); attn_phase(F, args, l); }
                __syncthreads();
                if (PHM & 256) { const Ctx F = relaunder(F0); hgrn_out_phase(F, args, l); }
            }
            else if ((PHM & 512) && sp == 8) {
                const Ctx F = relaunder(F0);
                pg8::Gemm g{Y, WL + O_WB, NTOK, 4096, 256, D, 2, 512}; pg8::StaticOrder S; S.init(NTOK, 4096, 256, F.G, F.bid);
                pg8::EpiGate E{PB + C_GATE, INW};
                pg8::gemm_phase<pg8::EpiGate, pg8::StaticOrder>(F.lds, g, S, E, F.tid);
            } else if ((PHM & 1024) && sp == 9) { const Ctx F = relaunder(F0); sum4_phase(F, PB, XN); }
            else if ((PHM & 1024) && sp == 10) {
                const Ctx F = relaunder(F0);
                pg8::Gemm g{XN, WL + O_WO4, NTOK, D, D, D, 30, 0}; pg8::ResidOrder S; S.init(D, 8, F.G, F.bid);
                pg8::EpiResid E{X, modl, 5, rep == 0 ? 1.0f : 0.0f, D / 64, (float*)(ws + WS_PART), 1};
                pg8::gemm_phase<pg8::EpiResid, pg8::ResidOrder>(F.lds, g, S, E, F.tid);
            }
        }
        }
        if (ph + 1 < args.ph_hi) { if (ph == 0) grid.sync(); else xcd_barrier(xbar); if (PROBE_DBL & 128) xcd_barrier(xbar); }
    }
}

extern "C" void kernel_launch(void* const* d_in, const int* in_sizes, int n_in, void* d_out, int out_size, void* d_ws, size_t ws_size, hipStream_t stream) {
    static int grid = 0;
    if (grid == 0) {
        if (n_in != 26 || in_sizes[0] != SEQ * D || out_size != SEQ * D || ws_size < WS_END) {
            fprintf(stderr, "kernel_launch: unexpected shapes (n_in %d, in0 %d, out %d, ws %zu, need %zu); nothing launched\n", n_in, n_in > 0 ? in_sizes[0] : -1, out_size, ws_size, (size_t)WS_END); grid = -1; return; }
        int dev = 0, cus = 0, per_cu = 0;
        hipGetDevice(&dev); hipDeviceGetAttribute(&cus, hipDeviceAttributeMultiprocessorCount, dev);
        if (hipFuncSetAttribute((const void*)mk_fwd, hipFuncAttributeMaxDynamicSharedMemorySize, LDS_BYTES) != hipSuccess) { fprintf(stderr, "kernel_launch: hipFuncSetAttribute failed\n"); grid = -1; return; }
        if (hipOccupancyMaxActiveBlocksPerMultiprocessor(&per_cu, (const void*)mk_fwd, 512, LDS_BYTES) != hipSuccess || per_cu < 1) { fprintf(stderr, "kernel_launch: occupancy query says %d blocks per CU\n", per_cu); per_cu = 1; }
        (void)hipGetLastError();
        grid = cus * (per_cu > 1 ? 1 : per_cu);
        if (grid <= 0) grid = 256;
    }
    if (grid < 0) return;
    if (hipMemsetAsync(d_ws, 0, 16384, stream) != hipSuccess) { fprintf(stderr, "kernel_launch: hipMemsetAsync failed\n"); return; }
    Args a{};
    for (int i = 0; i < 26; ++i) a.in[i] = (const float*)d_in[i];
    a.out = (float*)d_out; a.ws = (unsigned char*)d_ws;
#if MK_PER_PHASE
    for (int ph = 0; ph < NPHASE; ++ph) { a.ph_lo = ph; a.ph_hi = ph + 1; hipLaunchKernelGGL(mk_fwd, dim3(grid), dim3(512), LDS_BYTES, stream, a); }
#else
    a.ph_lo = 0; a.ph_hi = NPHASE;
    void* kargs[] = {&a};
    hipError_t e = hipLaunchCooperativeKernel((const void*)mk_fwd, dim3(grid), dim3(512), kargs, LDS_BYTES, stream);
    if (e != hipSuccess) fprintf(stderr, "kernel_launch: cooperative launch failed: %s (grid %d)\n", hipGetErrorString(e), grid);
#endif
}
```

```cpp
#include <hip/hip_runtime.h>
#include <hip/hip_cooperative_groups.h>
#include <cstdio>
#include <cstdint>
namespace cg = cooperative_groups;

#ifndef MK_PER_PHASE
#define MK_PER_PHASE 0
#endif

#ifndef PROBE_DBL
#define PROBE_DBL 0
#endif
#ifndef PHM
#define PHM 0xffff
#endif
#define LAS __attribute__((address_space(3)))
typedef unsigned short bf16_t;
typedef short bf16x8 __attribute__((ext_vector_type(8)));
typedef short s16x4 __attribute__((ext_vector_type(4)));
typedef float f32x4 __attribute__((ext_vector_type(4)));
typedef float f32x16 __attribute__((ext_vector_type(16)));
typedef unsigned u32x4 __attribute__((ext_vector_type(4)));
typedef unsigned u32x2 __attribute__((ext_vector_type(2)));

constexpr int D = 1024, SEQ = 16384, CTX = 256, NTOK = SEQ + CTX, DEPTH = 4, DFF = 2816, INW = 6912, NMODV = 9 * 1024;
constexpr int C_AQ = 0, C_AK = 256, C_AV = 384, C_BQ = 512, C_BFF = 768, C_BFB = 1024, C_BI = 1280, C_BG = 1536, C_CX = 1792, C_DQ = 2048, C_DK = 2304, C_DV = 2560, C_GATE = 2816;
constexpr int NCHUNK = NTOK / 64;
constexpr float EPSN = 1e-6f;
constexpr float LOG2E = 1.4426950408889634f;
constexpr float ATT_SCALE = 0.125f;

constexpr size_t O_WGU1 = 0, O_WD1 = O_WGU1 + (size_t)2 * DFF * D, O_WIN = O_WD1 + (size_t)D * DFF, O_WB = O_WIN + (size_t)INW * D, O_WO4 = O_WB + (size_t)4096 * 256,
                 O_WGU2 = O_WO4 + (size_t)1024 * 1024, O_WD2 = O_WGU2 + (size_t)2 * DFF * D, LAYER_W = O_WD2 + (size_t)D * DFF;
constexpr size_t WS_W = 1u << 20;
constexpr size_t WS_MOD = WS_W + LAYER_W * 2 * DEPTH;
constexpr size_t WS_X = WS_MOD + (size_t)DEPTH * 2 * NMODV * 4 + 1024;
constexpr size_t WS_XN = WS_X + (size_t)NTOK * D * 4;
constexpr size_t WS_HA = WS_XN + (size_t)NTOK * D * 2;
constexpr size_t WS_PB = WS_HA + (size_t)2 * NCHUNK * 4 * 64 * 4;
constexpr size_t WS_Y = WS_PB + (size_t)NTOK * INW * 2;
constexpr size_t WS_VTA = WS_Y + (size_t)NTOK * D * 2;
constexpr size_t WS_VTD = WS_VTA + (size_t)2 * 64 * NTOK * 2;
constexpr size_t WS_PART = WS_VTD + (size_t)4 * 64 * NTOK * 2;
constexpr size_t WS_END = WS_PART + (size_t)11 * 256 * 1024 * 4;
static_assert(WS_X % 256 == 0 && WS_XN % 256 == 0 && WS_PB % 256 == 0 && WS_Y % 256 == 0 && WS_VTA % 256 == 0, "ws align");
static_assert((size_t)2 * NCHUNK * 4 * 4096 * 4 <= (size_t)NTOK * D * 2, "GS overlay fits XN");

constexpr int LDS_BYTES = 148480;
constexpr int NSUB = 14;
constexpr int NPHASE = 1 + NSUB * DEPTH + 1;

__device__ __forceinline__ float bf2f(unsigned v) { return __uint_as_float(v << 16); }
typedef __bf16 bf16x2_t __attribute__((ext_vector_type(2)));
typedef float f32x2_t __attribute__((ext_vector_type(2)));
__device__ __forceinline__ unsigned pk2(float lo, float hi) { const f32x2_t v = {lo, hi}; const bf16x2_t b = __builtin_convertvector(v, bf16x2_t); return __builtin_bit_cast(unsigned, b); }
__device__ __forceinline__ unsigned f2bf(float f) { return pk2(f, 0.f) & 0xffffu; }
__device__ __forceinline__ float lo16(unsigned w) { return __uint_as_float(w << 16); }
__device__ __forceinline__ float hi16(unsigned w) { return __uint_as_float(w & 0xffff0000u); }
__device__ __forceinline__ float max3f(float a, float b, float c) { float r; asm("v_max3_f32 %0, %1, %2, %3" : "=v"(r) : "v"(a), "v"(b), "v"(c)); return r; }
template <int K> __device__ __forceinline__ float swz_xor(float v) { return __uint_as_float((unsigned)__builtin_amdgcn_ds_swizzle((int)__float_as_uint(v), (K << 10) | 0x1f)); }
__device__ __forceinline__ float xor32_sum(float v) { const auto rr = __builtin_amdgcn_permlane32_swap(__float_as_uint(v), __float_as_uint(v), false, false); return __uint_as_float(rr[0]) + __uint_as_float(rr[1]); }
__device__ __forceinline__ float xor32_max(float v) { const auto rr = __builtin_amdgcn_permlane32_swap(__float_as_uint(v), __float_as_uint(v), false, false); return fmaxf(__uint_as_float(rr[0]), __uint_as_float(rr[1])); }
__device__ __forceinline__ float wave_sum(float v) {
    v += swz_xor<1>(v); v += swz_xor<2>(v); v += swz_xor<4>(v); v += swz_xor<8>(v); v += swz_xor<16>(v);
    return xor32_sum(v);
}
__device__ __forceinline__ float sigmoidf_(float x) { return __builtin_amdgcn_rcpf(1.0f + __builtin_amdgcn_exp2f(-1.4426950408889634f * x)); }
__device__ __forceinline__ float siluf_(float x) { return x * __builtin_amdgcn_rcpf(1.0f + __builtin_amdgcn_exp2f(-1.4426950408889634f * x)); }

__device__ __forceinline__ void fadd_agent(float* p, float v) { (void)__hip_atomic_fetch_add(p, v, __ATOMIC_RELAXED, __HIP_MEMORY_SCOPE_AGENT); }

namespace pg8 {
constexpr int BM = 256, BK = 64, HALF = 128, HTB = HALF * BK * 2, STAGE_BYTES = 8 * HTB, NXCD = 8, WGM = 8;
__host__ __device__ __forceinline__ int lds_byte(int r, int c) { const int st = (r >> 4) * 2 + (c >> 5), rr = r & 15, cc = c & 31, ob = rr * 64 + cc * 2; return st * 1024 + (ob ^ (((ob >> 9) & 1) << 5)); }
__host__ __device__ __forceinline__ void stage_rc(int b, int& R, int& C) { const int st = b / 1024, sb = b % 1024, swz = sb ^ (((sb >> 9) & 1) << 5); R = (st >> 1) * 16 + swz / 64; C = (st & 1) * 32 + (swz % 64) / 2; }
__host__ __device__ __forceinline__ int perm32(int rho) { const int n = rho >> 4, i = rho & 15; return 8 * (i >> 2) + 4 * n + (i & 3); }

struct Unit { int pm, pn, kt0, nkt; };
struct Gemm { const bf16_t* A; const bf16_t* Bt; int M, N, K, lda, a_sh, a_str; };

struct StaticOrder {
    int nM, nN, nwg, G, c, nkt;
    __host__ __device__ void init(int M, int N, int K, int G_, int c_) { nM = M / BM; nN = N / BM; nwg = nM * nN; G = G_; c = c_; nkt = K / BK; }
    __host__ __device__ bool next(int i, Unit& u) const {
        const long L = (long)i * G + c; if (L >= nwg) return false;
        int wgid = (int)L; { const int q = nwg / NXCD, r = nwg % NXCD, xcd = wgid % NXCD, off = wgid / NXCD; wgid = (xcd < r ? xcd * (q + 1) : r * (q + 1) + (xcd - r) * q) + off; }
        const int nig = WGM * nN, gid = wgid / nig, fm = gid * WGM, gsz = (nM - fm) < WGM ? (nM - fm) : WGM;
        u.pm = fm + ((wgid % nig) % gsz); u.pn = (wgid % nig) / gsz; u.kt0 = 0; u.nkt = nkt; return true;
    }
};
struct ResidOrder {
    int G, c, nkt, ksplit;
    __host__ __device__ void init(int K, int ksplit_, int G_, int c_) { G = G_; c = c_; nkt = K / BK; ksplit = ksplit_; }
    __host__ __device__ bool next(int i, Unit& u) const {
        const long L = (long)i * G + c;
        const bool lat = L < 256; const int Lc = (int)L - 256;
        int wgid = (int)(L & 255); wgid = (wgid % NXCD) * (256 / NXCD) + wgid / NXCD;
        const int nig = WGM * 4, fm = (wgid / nig) * WGM;
        const int pm_l = fm + ((wgid % nig) % WGM), pn_l = (wgid % nig) / WGM, nk_s = nkt / ksplit;
        u.pm = lat ? pm_l : SEQ / BM; u.pn = lat ? pn_l : (Lc & 3); u.nkt = lat ? nkt : nk_s; u.kt0 = lat ? 0 : (Lc >> 2) * nk_s;
        return lat || (Lc < 4 * ksplit);
    }
};


struct EpiSwiglu {
    static constexpr bool PERM = false;
    bf16_t* H;
    __device__ __forceinline__ void operator()(const f32x4 (&acc)[2][2][4][2], const Unit& u, int wr, int wc, int fr, int fq) const {
        const int row0 = u.pm * BM + wr * 64 + fr;
#pragma unroll
        for (int ai = 0; ai < 2; ++ai)
#pragma unroll
            for (int m = 0; m < 4; ++m) {
                bf16_t* rowp = H + (size_t)(row0 + ai * HALF + m * 16) * DFF;
#pragma unroll
                for (int bj = 0; bj < 2; ++bj) {
                    const int hid = (u.pn * 8 + bj * 4 + wc) * 16 + 4 * fq;
                    const f32x4 g = acc[ai][bj][m][0], up = acc[ai][bj][m][1];
                    u32x2 w; w.x = pk2(siluf_(g[0]) * up[0], siluf_(g[1]) * up[1]); w.y = pk2(siluf_(g[2]) * up[2], siluf_(g[3]) * up[3]);
                    *(u32x2*)(rowp + hid) = w;
                }
            }
    }
};
struct EpiResid {
    static constexpr bool PERM = false;
    float* X; const float* modl; int sel; float coef; int nkt_full; float* part; int ksh;
    __device__ __forceinline__ void operator()(const f32x4 (&acc)[2][2][4][2], const Unit& u, int wr, int wc, int fr, int fq) const {
        const float* mv = modl + (u.pm == (SEQ / BM) ? NMODV : 0) + sel * 1024;
        const int col0 = u.pn * BM + wc * 32 + 4 * fq;
        const bool split = u.nkt != nkt_full;
        float* base = split ? part + ((ptrdiff_t)(u.kt0 >> ksh) * 256 - (ptrdiff_t)u.pm * BM) * D : X;
#pragma unroll
        for (int bj = 0; bj < 2; ++bj)
#pragma unroll
            for (int n = 0; n < 2; ++n) {
                const f32x4 gv = *(const f32x4*)(mv + col0 + bj * HALF + n * 16) * coef;
#pragma unroll
                for (int ai = 0; ai < 2; ++ai)
#pragma unroll
                    for (int m = 0; m < 4; ++m) {
                        float* p = base + (size_t)(u.pm * BM + ai * HALF + wr * 64 + m * 16 + fr) * D + col0 + bj * HALF + n * 16;
                        const f32x4 dv = gv * acc[ai][bj][m][n];
                        if (split) *(f32x4*)p = dv;
                        else { const f32x4 xo = *(const f32x4*)p; *(f32x4*)p = xo + dv; }
                    }
            }
    }
};
struct EpiPlain {
    static constexpr bool PERM = true;
    bf16_t* O; int ldc;
    __device__ __forceinline__ void operator()(const f32x4 (&acc)[2][2][4][2], const Unit& u, int wr, int wc, int fr, int fq) const {
        const int row0 = u.pm * BM + wr * 64 + fr, col0 = u.pn * BM + wc * 32 + 8 * fq;
#pragma unroll
        for (int ai = 0; ai < 2; ++ai)
#pragma unroll
            for (int m = 0; m < 4; ++m) {
                bf16_t* rowp = O + (size_t)(row0 + ai * HALF + m * 16) * ldc + col0;
#pragma unroll
                for (int bj = 0; bj < 2; ++bj) {
                    const f32x4 v0 = acc[ai][bj][m][0], v1 = acc[ai][bj][m][1];
                    u32x4 w; w.x = pk2(v0[0], v0[1]); w.y = pk2(v0[2], v0[3]); w.z = pk2(v1[0], v1[1]); w.w = pk2(v1[2], v1[3]);
                    *(u32x4*)(rowp + bj * HALF) = w;
                }
            }
    }
};
struct EpiGate {
    static constexpr bool PERM = true;
    bf16_t* O; int ldc;
    __device__ __forceinline__ void operator()(const f32x4 (&acc)[2][2][4][2], const Unit& u, int wr, int wc, int fr, int fq) const {
        const int row0 = u.pm * BM + wr * 64 + fr, col0 = u.pn * BM + wc * 32 + 8 * fq;
#pragma unroll
        for (int ai = 0; ai < 2; ++ai)
#pragma unroll
            for (int m = 0; m < 4; ++m) {
                bf16_t* rowp = O + (size_t)(row0 + ai * HALF + m * 16) * ldc + col0;
#pragma unroll
                for (int bj = 0; bj < 2; ++bj) {
                    u32x4 gp = *(const u32x4*)(rowp + bj * HALF);
                    const f32x4 v0 = acc[ai][bj][m][0], v1 = acc[ai][bj][m][1];
                    gp.x = pk2(sigmoidf_(lo16(gp.x)) * v0[0], sigmoidf_(hi16(gp.x)) * v0[1]); gp.y = pk2(sigmoidf_(lo16(gp.y)) * v0[2], sigmoidf_(hi16(gp.y)) * v0[3]);
                    gp.z = pk2(sigmoidf_(lo16(gp.z)) * v1[0], sigmoidf_(hi16(gp.z)) * v1[1]); gp.w = pk2(sigmoidf_(lo16(gp.w)) * v1[2], sigmoidf_(hi16(gp.w)) * v1[3]);
                    *(u32x4*)(rowp + bj * HALF) = gp;
                    asm volatile("" ::: "memory");
                }
            }
    }
};

template <class Epi, class Sched>
__device__ __forceinline__ void gemm_phase(LAS unsigned char* lds, const Gemm g, const Sched& S, const Epi& E, const int tid) {
    const int wid = __builtin_amdgcn_readfirstlane(tid >> 6), lane = tid & 63, wr = wid >> 2, wc = wid & 3, fr = lane & 15, fq = lane >> 4;
    const int K = g.K, lda = g.lda;
    unsigned voffA[2], voffB[2];
#pragma unroll
    for (int i = 0; i < 2; ++i) { int R, C; stage_rc(tid * 16 + i * 8192, R, C); const int Rb = Epi::PERM ? ((R & ~31) + perm32(R & 31)) : R;
        voffA[i] = (unsigned)(R * lda + C) * 2u; voffB[i] = (unsigned)(Rb * K + C) * 2u; }
    const size_t kstep = (size_t)(BK * 2);
    const size_t hstepA = (size_t)HALF * lda * 2, hstepB = (size_t)HALF * K * 2;
    const size_t tstepA = 2 * hstepA, tstepB = 2 * hstepB;
    const unsigned ldsw = (unsigned)wid * 1024u;
    const int aoff = lds_byte(wr * 64 + fr, fq * 8), boff = lds_byte(wc * 32 + fr, fq * 8);
#define PG8_UA(u) ((const char*)g.A + (size_t)(u).pm * tstepA + (size_t)(((u).pn >> g.a_sh) * g.a_str) + (size_t)(u).kt0 * kstep)
#define PG8_UB(u) ((const char*)g.Bt + (size_t)(u).pn * tstepB + (size_t)(u).kt0 * kstep)
#define PG8_SA(b, h) (((b) * 2 + (h)) * HTB)
#define PG8_SB(b, h) ((4 + (b) * 2 + (h)) * HTB)
#define PG8_STAGE(bufoff, gbase, voff) do { _Pragma("unroll") for (int _i = 0; _i < 2; ++_i) \
        __builtin_amdgcn_global_load_lds((const unsigned*)((const char*)(gbase) + (voff)[_i]), (LAS unsigned*)(lds + (bufoff) + ldsw + _i * 8192), 16, 0, 0); } while (0)
#define PG8_LDA(dst, b, h) do { _Pragma("unroll") for (int m = 0; m < 4; ++m) _Pragma("unroll") for (int k = 0; k < 2; ++k) dst[m][k] = *(const LAS bf16x8*)(lds + PG8_SA(b, h) + aoff + m * 2048 + k * 1024); } while (0)
#define PG8_LDB(dst, b, h) do { _Pragma("unroll") for (int n = 0; n < 2; ++n) _Pragma("unroll") for (int k = 0; k < 2; ++k) dst[n][k] = *(const LAS bf16x8*)(lds + PG8_SB(b, h) + boff + n * 2048 + k * 1024); } while (0)
#define PG8_MMA(ai, bj, At, Bt) do { __builtin_amdgcn_s_setprio(1); _Pragma("unroll") for (int m = 0; m < 4; ++m) _Pragma("unroll") for (int n = 0; n < 2; ++n) _Pragma("unroll") for (int k = 0; k < 2; ++k) \
        acc[ai][bj][m][n] = __builtin_amdgcn_mfma_f32_16x16x32_bf16(Bt[n][k], At[m][k], acc[ai][bj][m][n], 0, 0, 0); __builtin_amdgcn_s_setprio(0); } while (0)
#define PG8_WAIT_V(n) asm volatile("s_waitcnt vmcnt(" #n ")" ::: "memory")
#define PG8_WAIT_L(n) asm volatile("s_waitcnt lgkmcnt(" #n ")" ::: "memory")
#define PG8_BAR __builtin_amdgcn_s_barrier()
#define PG8_SCHED __builtin_amdgcn_sched_barrier(0)
    Unit cur, nxt; int ui = 0;
    if (!S.next(0, cur)) return;
    f32x4 acc[2][2][4][2];
#pragma unroll
    for (int a = 0; a < 2; ++a)
#pragma unroll
        for (int b = 0; b < 2; ++b)
#pragma unroll
            for (int m = 0; m < 4; ++m)
#pragma unroll
                for (int n = 0; n < 2; ++n) acc[a][b][m][n] = (f32x4){0.f, 0.f, 0.f, 0.f};
    bf16x8 At[4][2], B0[2][2], B1[2][2];
    const char* cA = PG8_UA(cur); const char* cB = PG8_UB(cur);
    PG8_STAGE(PG8_SB(0, 0), cB, voffB); PG8_STAGE(PG8_SB(0, 1), cB + hstepB, voffB); PG8_STAGE(PG8_SA(0, 0), cA, voffA); PG8_STAGE(PG8_SA(0, 1), cA + hstepA, voffA);
    if (wr == 1) PG8_BAR;
    PG8_WAIT_V(2); PG8_BAR;
    PG8_STAGE(PG8_SB(1, 0), cB + kstep, voffB); PG8_STAGE(PG8_SA(1, 0), cA + kstep, voffA); PG8_STAGE(PG8_SB(1, 1), cB + hstepB + kstep, voffB);
    PG8_WAIT_V(6); PG8_BAR;
    for (;;) {
        const bool has_next = S.next(ui + 1, nxt);
        const char* nA = has_next ? PG8_UA(nxt) : cA; const char* nB = has_next ? PG8_UB(nxt) : cB;
        const int nt = cur.nkt;
#pragma unroll 1
        for (int t = 0; t < nt; t += 2) {
            const bool last = (t == nt - 2);
            const char* a1 = cA + (size_t)(t + 1) * kstep;
            const char* a2 = last ? nA : cA + (size_t)(t + 2) * kstep; const char* b2 = last ? nB : cB + (size_t)(t + 2) * kstep;
            const char* a3 = a2 + kstep; const char* b3 = b2 + kstep;
            PG8_LDB(B0, 0, 0); PG8_LDB(B1, 0, 1); PG8_SCHED; PG8_LDA(At, 0, 0); PG8_STAGE(PG8_SA(1, 1), a1 + hstepA, voffA);
            PG8_WAIT_V(8); PG8_WAIT_L(0); PG8_BAR; PG8_MMA(0, 0, At, B0); PG8_MMA(0, 1, At, B1); PG8_BAR; PG8_SCHED;
            PG8_LDA(At, 0, 1); PG8_STAGE(PG8_SB(0, 0), b2, voffB); PG8_STAGE(PG8_SB(0, 1), b2 + hstepB, voffB); PG8_STAGE(PG8_SA(0, 0), a2, voffA);
            PG8_WAIT_V(8); PG8_WAIT_L(0); PG8_BAR; PG8_MMA(1, 0, At, B0); PG8_MMA(1, 1, At, B1); PG8_BAR; PG8_SCHED;
            PG8_LDB(B0, 1, 0); PG8_LDB(B1, 1, 1); PG8_SCHED; PG8_LDA(At, 1, 0); PG8_STAGE(PG8_SA(0, 1), a2 + hstepA, voffA);
            PG8_WAIT_V(8); PG8_WAIT_L(0); PG8_BAR; PG8_MMA(0, 0, At, B0); PG8_MMA(0, 1, At, B1); PG8_BAR; PG8_SCHED;
            PG8_LDA(At, 1, 1); PG8_STAGE(PG8_SB(1, 0), b3, voffB); PG8_STAGE(PG8_SB(1, 1), b3 + hstepB, voffB); PG8_STAGE(PG8_SA(1, 0), a3, voffA);
            PG8_WAIT_V(8); PG8_WAIT_L(0); PG8_BAR; PG8_MMA(1, 0, At, B0); PG8_MMA(1, 1, At, B1); PG8_BAR; PG8_SCHED;
        }
        if (wr == 0) PG8_BAR;
        E(acc, cur, wr, wc, fr, fq);
        if (!has_next) break;
#pragma unroll
        for (int a = 0; a < 2; ++a)
#pragma unroll
            for (int b = 0; b < 2; ++b)
#pragma unroll
                for (int m = 0; m < 4; ++m)
#pragma unroll
                    for (int n = 0; n < 2; ++n) acc[a][b][m][n] = (f32x4){0.f, 0.f, 0.f, 0.f};
        cur = nxt; cA = nA; cB = nB; ++ui;
        if (wr == 1) PG8_BAR;
    }
    PG8_WAIT_V(0);
    PG8_BAR;
#undef PG8_UA
#undef PG8_UB
#undef PG8_SA
#undef PG8_SB
#undef PG8_STAGE
#undef PG8_LDA
#undef PG8_LDB
#undef PG8_MMA
#undef PG8_WAIT_V
#undef PG8_WAIT_L
#undef PG8_BAR
#undef PG8_SCHED
}
}

struct Args {
    const float* in[26];
    float* out; unsigned char* ws;
    int ph_lo, ph_hi;
};
__device__ __forceinline__ const float* in_ptr(int i) {
    const __attribute__((address_space(4))) char* ka = (const __attribute__((address_space(4))) char*)__builtin_amdgcn_kernarg_segment_ptr();
    int off = i * 8; asm volatile("" : "+s"(off));
    return *(const float* const __attribute__((address_space(4)))*)(ka + off);
}
struct Ctx {
    LAS unsigned char* lds;
    int tid, lane, wave, G, bid, gw, ngw;
};

__device__ __forceinline__ void transpose_item(const float* __restrict__ W, int K, int N, bf16_t* __restrict__ WT, int ldw, int koff, int row_off, int mode, LAS float* scr, int item, int lane) {
    const int nblk = N / 32, kb = item / nblk, nb = item % nblk, k0 = 64 * kb, n0 = 32 * nb;
#pragma unroll
    for (int i = 0; i < 32; ++i) { const int kk = 2 * i + (lane >> 5); scr[kk * 33 + (lane & 31)] = W[(size_t)(k0 + kk) * N + n0 + (lane & 31)]; }
    asm volatile("s_waitcnt lgkmcnt(0)" ::: "memory");
    const int c = lane & 7;
#pragma unroll
    for (int j = 0; j < 4; ++j) { const int n = (lane >> 3) + 8 * j; const LAS float* s = scr + (8 * c) * 33 + n;
        u32x4 o; o.x = pk2(s[0 * 33], s[1 * 33]); o.y = pk2(s[2 * 33], s[3 * 33]); o.z = pk2(s[4 * 33], s[5 * 33]); o.w = pk2(s[6 * 33], s[7 * 33]);
        const int ng = n0 + n;
        const int dr = mode == 0 ? ng : (((ng >> 4) << 5) + (ng & 15) + (mode == 2 ? 16 : 0));
        *(u32x4*)(WT + (size_t)(row_off + dr) * ldw + koff + k0 + 8 * c) = o; }
    asm volatile("s_waitcnt lgkmcnt(0)" ::: "memory");
}

__device__ __forceinline__ void phase0(const Ctx& F, const Args& a) {
    unsigned char* ws = a.ws;
    {
        LAS float* sc = (LAS float*)F.lds;
        const float* cvec = in_ptr(1); const float* cctx = in_ptr(3); const float* w_ada = in_ptr(4); const float* b_ada = in_ptr(5);
        float* MOD = (float*)(ws + WS_MOD);
        for (int k = F.tid; k < 2048; k += 512) { const float c = (k < 1024) ? cvec[k] : cctx[k - 1024]; sc[k] = siluf_(c); }
        __syncthreads();
        LAS float* red = sc + 2048;
        for (int it = F.bid; it < DEPTH * 144; it += F.G) {
            const int l = it / 144, n = (it % 144) * 64 + F.lane, k0 = F.wave * 128;
            const float* w = w_ada + (size_t)l * D * NMODV + (size_t)k0 * NMODV + n; float a0 = 0.f, a1 = 0.f;
#pragma unroll 16
            for (int k = 0; k < 128; ++k) { const float wv = w[(size_t)k * NMODV]; a0 += sc[k0 + k] * wv; a1 += sc[1024 + k0 + k] * wv; }
            red[(F.wave * 2 + 0) * 64 + F.lane] = a0; red[(F.wave * 2 + 1) * 64 + F.lane] = a1;
            __syncthreads();
            if (F.wave < 2) { float s = b_ada[l * NMODV + n];
#pragma unroll
                for (int ww = 0; ww < 8; ++ww) s += red[(ww * 2 + F.wave) * 64 + F.lane];
                MOD[(size_t)(l * 2 + F.wave) * NMODV + n] = s; }
            __syncthreads();
        }
    }
    {
        LAS float* scr = (LAS float*)(F.lds + F.wave * 16384);
        constexpr int I_FF = 16 * 88, I_DN = 44 * 32, I_IN = 16 * 216, I_B = 4 * 32, I_O = 16 * 32;
        constexpr int PER_LAYER = 4 * I_FF + 2 * I_DN + I_IN + 4 * I_B + I_O;
        for (int it = F.gw; it < PER_LAYER * DEPTH; it += F.ngw) {
            const int l = it / PER_LAYER; int r = it % PER_LAYER;
            bf16_t* WL = (bf16_t*)(ws + WS_W) + (size_t)l * LAYER_W;
            if (r < I_FF) { transpose_item(in_ptr(7) + (size_t)l * D * DFF, D, DFF, WL + O_WGU1, D, 0, 0, 1, scr, r, F.lane); continue; } r -= I_FF;
            if (r < I_FF) { transpose_item(in_ptr(8) + (size_t)l * D * DFF, D, DFF, WL + O_WGU1, D, 0, 0, 2, scr, r, F.lane); continue; } r -= I_FF;
            if (r < I_DN) { transpose_item(in_ptr(9) + (size_t)l * DFF * D, DFF, D, WL + O_WD1, DFF, 0, 0, 0, scr, r, F.lane); continue; } r -= I_DN;
            if (r < I_IN) { transpose_item(in_ptr(11) + (size_t)l * D * INW, D, INW, WL + O_WIN, D, 0, 0, 0, scr, r, F.lane); continue; } r -= I_IN;
            if (r < 4 * I_B) { const int b = r / I_B; transpose_item(in_ptr(19) + ((size_t)l * 4 + b) * 256 * D, 256, D, WL + O_WB, 256, 0, b * 1024, 0, scr, r % I_B, F.lane); continue; } r -= 4 * I_B;
            if (r < I_O) { transpose_item(in_ptr(20) + (size_t)l * D * D, D, D, WL + O_WO4, D, 0, 0, 0, scr, r, F.lane); continue; } r -= I_O;
            if (r < I_FF) { transpose_item(in_ptr(22) + (size_t)l * D * DFF, D, DFF, WL + O_WGU2, D, 0, 0, 1, scr, r, F.lane); continue; } r -= I_FF;
            if (r < I_FF) { transpose_item(in_ptr(23) + (size_t)l * D * DFF, D, DFF, WL + O_WGU2, D, 0, 0, 2, scr, r, F.lane); continue; } r -= I_FF;
            transpose_item(in_ptr(24) + (size_t)l * DFF * D, DFF, D, WL + O_WD2, DFF, 0, 0, 0, scr, r, F.lane);
        }
    }
    {
        f32x4* X4 = (f32x4*)(ws + WS_X); const f32x4* x4 = (const f32x4*)in_ptr(0); const f32x4* c4 = (const f32x4*)in_ptr(2);
        const size_t n1 = (size_t)SEQ * D / 4, n2 = (size_t)CTX * D / 4;
        for (size_t i = (size_t)F.bid * 512 + F.tid; i < n1 + n2; i += (size_t)F.G * 512) X4[i] = i < n1 ? x4[i] : c4[i - n1];
    }
}

__device__ __forceinline__ void norm_phase(const Ctx& F, float* X, const float* gw, const float* modl, int ish, int isc, bf16_t* XN, const float* part, int nsplit) {
    for (int row = SEQ + F.gw; row < NTOK; row += F.ngw) {
        const float* mv = modl + NMODV;
        f32x4* xr = (f32x4*)(X + (size_t)row * D) + F.lane;
        f32x4 v[4];
#pragma unroll
        for (int j = 0; j < 4; ++j) v[j] = xr[64 * j];
        const f32x4* pr = (const f32x4*)(part + (size_t)(row - SEQ) * D) + F.lane;
        int s = 0;
        for (; s + 4 <= nsplit; s += 4) {
            f32x4 t[4][4];
#pragma unroll
            for (int u = 0; u < 4; ++u)
#pragma unroll
                for (int j = 0; j < 4; ++j) t[u][j] = pr[(size_t)(s + u) * (256 * D / 4) + 64 * j];
#pragma unroll
            for (int u = 0; u < 4; ++u)
#pragma unroll
                for (int j = 0; j < 4; ++j) v[j] += t[u][j];
        }
        for (; s < nsplit; ++s)
#pragma unroll
            for (int j = 0; j < 4; ++j) v[j] += pr[(size_t)s * (256 * D / 4) + 64 * j];
        if (nsplit > 0) {
#pragma unroll
            for (int j = 0; j < 4; ++j) xr[64 * j] = v[j];
        }
        float ss = 0.f;
#pragma unroll
        for (int j = 0; j < 4; ++j) ss += (v[j].x * v[j].x + v[j].y * v[j].y) + (v[j].z * v[j].z + v[j].w * v[j].w);
        const float rs = __builtin_amdgcn_rsqf(wave_sum(ss) * (1.f / D) + EPSN);
#pragma unroll
        for (int j = 0; j < 4; ++j) {
            const int col = 4 * F.lane + 256 * j;
            const f32x4 g4 = *(const f32x4*)(gw + col), sh = *(const f32x4*)(mv + ish * 1024 + col), sc = *(const f32x4*)(mv + isc * 1024 + col);
            const f32x4 o = (v[j] * rs) * (g4 * (sc + 1.0f)) + sh;
            u32x2 w; w.x = pk2(o.x, o.y); w.y = pk2(o.z, o.w);
            *(u32x2*)(XN + (size_t)row * D + col) = w;
        }
    }
    for (int row0 = 4 * F.gw; row0 < SEQ; row0 += 4 * F.ngw) {
        const float* mv = modl;
        f32x4 v[4][4];
#pragma unroll
        for (int r = 0; r < 4; ++r) { const f32x4* xr = (const f32x4*)(X + (size_t)(row0 + r) * D) + F.lane;
#pragma unroll
            for (int j = 0; j < 4; ++j) v[r][j] = xr[64 * j]; }
        float rs[4];
#pragma unroll
        for (int r = 0; r < 4; ++r) { float ss = 0.f;
#pragma unroll
            for (int j = 0; j < 4; ++j) ss += (v[r][j].x * v[r][j].x + v[r][j].y * v[r][j].y) + (v[r][j].z * v[r][j].z + v[r][j].w * v[r][j].w);
            rs[r] = __builtin_amdgcn_rsqf(wave_sum(ss) * (1.f / D) + EPSN); }
#pragma unroll
        for (int j = 0; j < 4; ++j) {
            const int col = 4 * F.lane + 256 * j;
            const f32x4 g4 = *(const f32x4*)(gw + col), sh = *(const f32x4*)(mv + ish * 1024 + col), sc = *(const f32x4*)(mv + isc * 1024 + col);
            const f32x4 gs = g4 * (sc + 1.0f);
#pragma unroll
            for (int r = 0; r < 4; ++r) {
                const f32x4 o = (v[r][j] * rs[r]) * gs + sh;
                u32x2 w; w.x = pk2(o.x, o.y); w.y = pk2(o.z, o.w);
                *(u32x2*)(XN + (size_t)(row0 + r) * D + col) = w;
            }
        }
    }
}
__device__ __forceinline__ void final_norm_phase(const Ctx& F, const float* X, const float* gw, float* out) {
    for (int row = F.gw; row < SEQ; row += F.ngw) {
        const f32x4* xr = (const f32x4*)(X + (size_t)row * D) + F.lane;
        f32x4 v[4]; float ss = 0.f;
#pragma unroll
        for (int j = 0; j < 4; ++j) { v[j] = xr[64 * j]; ss += (v[j].x * v[j].x + v[j].y * v[j].y) + (v[j].z * v[j].z + v[j].w * v[j].w); }
        const float rs = 1.0f / sqrtf(wave_sum(ss) * (1.f / D) + EPSN);
#pragma unroll
        for (int j = 0; j < 4; ++j) { const int col = 4 * F.lane + 256 * j; *(f32x4*)(out + (size_t)row * D + col) = v[j] * rs * *(const f32x4*)(gw + col); }
    }
}

__device__ __forceinline__ void prep_qk(bf16_t* PB, int tok0, int col, const float* gain, bool rope, float outscale, int lane) {
    const int i = lane & 15, tq = lane >> 4;
    const float g0 = gain[i], g1 = gain[16 + i], g2 = gain[32 + i], g3 = gain[48 + i];
    const float inv = exp2f(-(float)i * 0.83048202372184059f);
#pragma unroll 4
    for (int pass = 0; pass < 16; ++pass) {
        const int tok = tok0 + pass * 4 + tq;
        bf16_t* p = PB + (size_t)tok * INW + col + i;
        float x0 = bf2f(p[0]), x1 = bf2f(p[16]), x2 = bf2f(p[32]), x3 = bf2f(p[48]);
        float ss = (x0 * x0 + x1 * x1) + (x2 * x2 + x3 * x3);
        ss += swz_xor<1>(ss); ss += swz_xor<2>(ss); ss += swz_xor<4>(ss); ss += swz_xor<8>(ss);
        const float r = 1.0f / sqrtf(ss * (1.f / 64.f) + EPSN);
        x0 = x0 * r * g0; x1 = x1 * r * g1; x2 = x2 * r * g2; x3 = x3 * r * g3;
        if (rope) {
            const float ar = (float)(tok >> 6) * inv, ac = (float)(tok & 63) * inv;
            const float sr = __sinf(ar), cr = __cosf(ar), sc = __sinf(ac), cc = __cosf(ac);
            const float a0 = x0, b0 = x1; x0 = a0 * cr - b0 * sr; x1 = b0 * cr + a0 * sr;
            const float a1 = x2, b1 = x3; x2 = a1 * cc - b1 * sc; x3 = b1 * cc + a1 * sc;
        }
        p[0] = (bf16_t)f2bf(x0 * outscale); p[16] = (bf16_t)f2bf(x1 * outscale); p[32] = (bf16_t)f2bf(x2 * outscale); p[48] = (bf16_t)f2bf(x3 * outscale);
    }
}
__device__ __forceinline__ void prep_vt(const bf16_t* PB, int tok0, int col, bf16_t* VT, LAS unsigned char* scr, int lane) {
    const bf16_t* p = PB + (size_t)(tok0 + lane) * INW + col;
    LAS unsigned* s32 = (LAS unsigned*)scr;
#pragma unroll
    for (int c = 0; c < 8; ++c) { const u32x4 w = *(const u32x4*)(p + 8 * c);
        s32[lane * 33 + 4 * c + 0] = w.x; s32[lane * 33 + 4 * c + 1] = w.y; s32[lane * 33 + 4 * c + 2] = w.z; s32[lane * 33 + 4 * c + 3] = w.w; }
    asm volatile("s_waitcnt lgkmcnt(0)" ::: "memory");
    const LAS bf16_t* s16 = (const LAS bf16_t*)scr;
    bf16_t* o = VT + (size_t)lane * NTOK + tok0;
#pragma unroll
    for (int c = 0; c < 8; ++c) { u32x4 w; unsigned t[8];
#pragma unroll
        for (int e = 0; e < 8; ++e) t[e] = s16[(8 * c + e) * 66 + lane];
        w.x = t[0] | (t[1] << 16); w.y = t[2] | (t[3] << 16); w.z = t[4] | (t[5] << 16); w.w = t[6] | (t[7] << 16);
        *(u32x4*)(o + 8 * c) = w; }
    asm volatile("s_waitcnt lgkmcnt(0)" ::: "memory");
}
__device__ __forceinline__ float lb_val(const float* logits, int l, int dir, int ch) {
    float v[4]; float mx = -3.0e38f;
#pragma unroll
    for (int j = 0; j < 4; ++j) { v[j] = logits[(j * 2 + dir) * 256 + ch]; mx = fmaxf(mx, v[j]); }
    float s = 0.f, c = 0.f;
#pragma unroll
    for (int j = 0; j < 4; ++j) { v[j] = expf(v[j] - mx); s += v[j]; if (j >= 1 && j <= l) c += v[j]; }
    return c / s;
}
__device__ __forceinline__ int hg_row(int dir, int c, int s) {
    const int p = 64 * c + s;
    if (dir == 0) return p < CTX ? SEQ + p : p - CTX;
    return p < CTX ? SEQ + (CTX - 1) - p : (SEQ - 1) - (p - CTX);
}
__device__ __forceinline__ void hgrn_h1_item(const Ctx& F, const bf16_t* PB, const float* logits, int l, int item, float* GS, float* HA, LAS unsigned char* scrb) {
    const int head = item & 3, c = (item >> 2) % NCHUNK, dir = item / (4 * NCHUNK), lane = F.lane, q_ = lane & 31, h = lane >> 5;
    constexpr int TP = 144;
    LAS unsigned char* TKh = scrb;
    const int colf = (dir ? C_BFB : C_BFF) + head * 64 + lane;
    const float lb = lb_val(logits, l, dir, head * 64 + lane);
    float r = 0.f;
#pragma unroll
    for (int cb = 7; cb >= 0; --cb) {
        float kh[8];
#pragma unroll
        for (int i = 7; i >= 0; --i) {
            const float pre = bf2f(PB[(size_t)hg_row(dir, c, 8 * cb + i) * INW + colf]);
            const float f = lb + (1.0f - lb) * sigmoidf_(pre);
            kh[i] = (1.0f - f) * __expf(r);
            r += __logf(f);
        }
        const u32x4 w = {pk2(kh[0], kh[1]), pk2(kh[2], kh[3]), pk2(kh[4], kh[5]), pk2(kh[6], kh[7])};
        *(LAS u32x4*)(TKh + lane * TP + 16 * cb) = w;
    }
    HA[(size_t)((dir * NCHUNK + c) * 4 + head) * 64 + lane] = __expf(r);
    asm volatile("s_waitcnt lgkmcnt(0)" ::: "memory");
    __builtin_amdgcn_wave_barrier();
    f32x16 g[2][2];
#pragma unroll
    for (int r2 = 0; r2 < 16; ++r2) { g[0][0][r2] = 0.f; g[0][1][r2] = 0.f; g[1][0][r2] = 0.f; g[1][1][r2] = 0.f; }
    const bf16_t* vbase = PB + C_BI + head * 64 + q_;
#pragma unroll
    for (int k = 0; k < 4; ++k) {
        const bf16x8 ka0 = *(const LAS bf16x8*)(TKh + q_ * TP + (16 * k + 8 * h) * 2), ka1 = *(const LAS bf16x8*)(TKh + (32 + q_) * TP + (16 * k + 8 * h) * 2);
#pragma unroll
        for (int vb = 0; vb < 2; ++vb) {
            unsigned e[8];
#pragma unroll
            for (int j = 0; j < 8; ++j) e[j] = vbase[(size_t)hg_row(dir, c, 16 * k + 8 * h + j) * INW + 32 * vb];
            const u32x4 w = {e[0] | (e[1] << 16), e[2] | (e[3] << 16), e[4] | (e[5] << 16), e[6] | (e[7] << 16)};
            const bf16x8 vf = __builtin_bit_cast(bf16x8, w);
            g[0][vb] = __builtin_amdgcn_mfma_f32_32x32x16_bf16(ka0, vf, g[0][vb], 0, 0, 0);
            g[1][vb] = __builtin_amdgcn_mfma_f32_32x32x16_bf16(ka1, vf, g[1][vb], 0, 0, 0);
        }
    }
    float* go = GS + ((size_t)((dir * NCHUNK + c) * 4 + head)) * 4096;
#pragma unroll
    for (int db = 0; db < 2; ++db)
#pragma unroll
        for (int vb = 0; vb < 2; ++vb)
#pragma unroll
            for (int r2 = 0; r2 < 16; ++r2) go[(32 * db + 8 * (r2 >> 2) + 4 * h + (r2 & 3)) * 64 + 32 * vb + q_] = g[db][vb][r2];
    asm volatile("s_waitcnt lgkmcnt(0)" ::: "memory");
    __builtin_amdgcn_wave_barrier();
}
__device__ __forceinline__ void pool_item(const Ctx& F, const bf16_t* PB, const float* wg  , const float* cscale  , bf16_t* Y, int item, LAS unsigned char* scrb) {
    const int g = item & 3, tile = item >> 2, lane = F.lane, q_ = lane & 31, h = lane >> 5;
    const int row0 = tile * 64, sb = row0 >= SEQ ? SEQ : 0, T = row0 >= SEQ ? CTX : SEQ, t0 = row0 - sb;
    const int half = 1 << g;
    LAS bf16_t* xs = (LAS bf16_t*)scrb;
    LAS unsigned char* PT = scrb + 10240;
    const bf16_t* xp = PB + (size_t)sb * INW + C_CX + 64 * g + lane;
#pragma clang loop vectorize(disable) interleave(disable) unroll_count(8)
    for (int i = 0; i < 80; ++i) { const int uc = min(max(t0 - 8 + i, 0), T - 1); xs[i * 64 + lane] = xp[(size_t)uc * INW]; }
    asm volatile("s_waitcnt lgkmcnt(0)" ::: "memory");
    float s = 0.f; int cnt = 0;
#pragma unroll
    for (int k = 0; k < 16; ++k) { const int dk = k - 8, u = t0 + dk; const bool ok = (dk >= -half) && (dk < half) && (u >= 0) && (u < T);
        const float xv = bf2f(xs[(8 + dk) * 64 + lane]); s += ok ? xv : 0.f; cnt += ok ? 1 : 0; }
#pragma unroll 4
    for (int tt = 0; tt < 64; ++tt) {
        if (tt > 0) { const int t = t0 + tt;
            if (t - 1 + half < T) { s += bf2f(xs[(tt + 7 + half) * 64 + lane]); ++cnt; }
            if (t - 1 - half >= 0) { s -= bf2f(xs[(tt + 7 - half) * 64 + lane]); --cnt; } }
        const float pooled = s * __builtin_amdgcn_rcpf((float)cnt) - bf2f(xs[(tt + 8) * 64 + lane]);
        *(LAS bf16_t*)(PT + tt * 128 + 2 * lane) = (bf16_t)f2bf(pooled);
    }
    asm volatile("s_waitcnt lgkmcnt(0)" ::: "memory");
    __builtin_amdgcn_wave_barrier();
    f32x16 acc[2][2];
#pragma unroll
    for (int r = 0; r < 16; ++r) { acc[0][0][r] = 0.f; acc[0][1][r] = 0.f; acc[1][0][r] = 0.f; acc[1][1][r] = 0.f; }
    const float* wp = wg + (size_t)g * 4096 + q_;
#pragma unroll
    for (int k = 0; k < 4; ++k) {
        const bf16x8 a0 = *(const LAS bf16x8*)(PT + q_ * 128 + (16 * k + 8 * h) * 2), a1 = *(const LAS bf16x8*)(PT + (32 + q_) * 128 + (16 * k + 8 * h) * 2);
#pragma unroll
        for (int vb = 0; vb < 2; ++vb) {
            float wv[8];
#pragma unroll
            for (int j = 0; j < 8; ++j) wv[j] = wp[(16 * k + 8 * h + j) * 64 + 32 * vb];
            const u32x4 w = {pk2(wv[0], wv[1]), pk2(wv[2], wv[3]), pk2(wv[4], wv[5]), pk2(wv[6], wv[7])};
            const bf16x8 wf = __builtin_bit_cast(bf16x8, w);
            acc[0][vb] = __builtin_amdgcn_mfma_f32_32x32x16_bf16(a0, wf, acc[0][vb], 0, 0, 0);
            acc[1][vb] = __builtin_amdgcn_mfma_f32_32x32x16_bf16(a1, wf, acc[1][vb], 0, 0, 0);
        }
    }
#pragma unroll
    for (int vb = 0; vb < 2; ++vb) {
        const float sc = cscale[64 * g + 32 * vb + q_];
#pragma unroll
        for (int tb = 0; tb < 2; ++tb)
#pragma unroll
            for (int r = 0; r < 16; ++r)
                Y[(size_t)(row0 + 32 * tb + 8 * (r >> 2) + 4 * h + (r & 3)) * D + 512 + 64 * g + 32 * vb + q_] = (bf16_t)f2bf(acc[tb][vb][r] * sc);
    }
    asm volatile("s_waitcnt lgkmcnt(0)" ::: "memory");
    __builtin_amdgcn_wave_barrier();
}

__device__ __forceinline__ void prep_h1_phase(LAS unsigned char* lds, unsigned char* ws, const float* logits, int l, int tid, int bid, int G) {
    Ctx F; F.lds = lds; F.tid = tid; F.lane = tid & 63; F.wave = __builtin_amdgcn_readfirstlane(tid >> 6); F.G = G; F.bid = bid; F.gw = bid * 8 + F.wave; F.ngw = G * 8;
    const bf16_t* PB = (const bf16_t*)(ws + WS_PB); float* GS = (float*)(ws + WS_XN); float* HA = (float*)(ws + WS_HA);
    LAS unsigned char* scr = F.lds + F.wave * 18432;
    for (int it = F.wave * F.G + F.bid; it < 2 * NCHUNK * 4; it += F.ngw) hgrn_h1_item(F, PB, logits, l, it, GS, HA, scr);
}
__device__ __forceinline__ void prep_pool_phase(const Ctx& F, const Args& a, int l) {
    unsigned char* ws = a.ws;
    const bf16_t* PB = (const bf16_t*)(ws + WS_PB); bf16_t* Y = (bf16_t*)(ws + WS_Y);
    LAS unsigned char* scr = F.lds + F.wave * 18432;
    for (int it = (7 - F.wave) * F.G + F.bid; it < NCHUNK * 4; it += F.ngw) pool_item(F, PB, in_ptr(16) + (size_t)l * 4 * 4096, in_ptr(17) + l * 256, Y, it, scr);
}
__device__ __forceinline__ void prep_qkv_phase(const Ctx& F, const Args& a, int l, int rep) {
    unsigned char* ws = a.ws;
    bf16_t* PB = (bf16_t*)(ws + WS_PB);
    bf16_t* VTA = (bf16_t*)(ws + WS_VTA); bf16_t* VTD = (bf16_t*)(ws + WS_VTD);
    LAS unsigned char* scr = F.lds + F.wave * 18432;
    const int nq = 4 * F.G, sl = (F.wave & 3) * F.G + F.bid;
    const int it_first = F.wave < 4 ? sl : 2 * nq + sl, it_step = F.wave < 4 ? nq : nq, it_end = F.wave < 4 ? 2 * nq : NCHUNK * 12;
    for (int it = it_first; it < it_end && it < NCHUNK * 12; it += it_step) {
        const int tile = it / 12, slot = it % 12, tok0 = tile * 64;
        int ln = F.lane; asm volatile("" : "+v"(ln));
        if (slot < 6 && rep > 0) continue;
        if (slot < 4) prep_qk(PB, tok0, C_AQ + 64 * slot, in_ptr(12) + l * 64, tok0 < SEQ, ATT_SCALE * LOG2E, ln);
        else if (slot < 6) prep_qk(PB, tok0, C_AK + 64 * (slot - 4), in_ptr(13) + l * 64, tok0 < SEQ, 1.0f, ln);
        else if (slot < 8) prep_vt(PB, tok0, C_AV + 64 * (slot - 6), VTA + (size_t)(slot - 6) * 64 * NTOK, scr, ln);
        else prep_vt(PB, tok0, C_DV + 64 * (slot - 8), VTD + (size_t)(slot - 8) * 64 * NTOK, scr, ln);
    }
}

template <bool NA>
__device__ __forceinline__ void attn_unit(LAS unsigned char* lds, const bf16_t* __restrict__ PB, const bf16_t* __restrict__ VT, bf16_t* __restrict__ Y,
                                          int q_tok0, int qcol, int kcol, int ycol, int ntiles, int loc_base, float qs,
                                          int na_r, int na_rs_base, int na_qc0, const float* relb, const int tid) {
    const int lane = tid & 63, q = lane & 31, h = lane >> 5;
    constexpr int KB = 9216, VB = 9216, VOFF = 2 * KB, BOFF = VOFF + 2 * VB;
    LAS float* biasL = (LAS float*)(lds + BOFF);
    bf16x8 qb[4];
    { const bf16_t* qp = PB + (size_t)(q_tok0 + q) * INW + qcol + 8 * h;
#pragma unroll
      for (int s = 0; s < 4; ++s) qb[s] = *(const bf16x8*)(qp + 16 * s); }
    __syncthreads();
    if (NA) { for (int i = tid; i < 465; i += 512) biasL[i] = relb[i] * LOG2E; }
    f32x16 o0, o1, negm;
#pragma unroll
    for (int r = 0; r < 16; ++r) { o0[r] = 0.f; o1[r] = 0.f; negm[r] = 0.f; }
    float m = 0.f, l = 0.f;
    const int srow = tid >> 3, sch = tid & 7;
    u32x4 kreg, vreg;
    { const int t0 = SEQ;
      kreg = *(const u32x4*)(PB + (size_t)(t0 + srow) * INW + kcol + 8 * sch); vreg = *(const u32x4*)(VT + (size_t)srow * NTOK + t0 + 8 * sch); }
    *(LAS u32x4*)(lds + srow * 144 + sch * 16) = kreg;
    { LAS unsigned char* vp = lds + VOFF + srow * 144 + (sch >> 1) * 32 + (sch & 1) * 8;
      *(LAS u32x2*)vp = (u32x2){vreg.x, vreg.y}; *(LAS u32x2*)(vp + 16) = (u32x2){vreg.z, vreg.w}; }
    __syncthreads();
    const int na_cs = NA ? min(max(na_qc0 + q - 8, 0), 48) : 0;
    const int na_rs = NA ? min(max(na_r - 4, 0), 248) : 0;
    for (int j = 0; j < ntiles; ++j) {
        const int cur = j & 1;
        if (j + 1 < ntiles) { const int t0 = (j + 1) < 4 ? SEQ + 64 * (j + 1) : loc_base + 64 * (j + 1 - 4);
            kreg = *(const u32x4*)(PB + (size_t)(t0 + srow) * INW + kcol + 8 * sch); vreg = *(const u32x4*)(VT + (size_t)srow * NTOK + t0 + 8 * sch); }
        bool active = true; int kr = 0;
        if (NA && j >= 4) { kr = na_rs_base + (j - 4); active = (kr >= na_rs) && (kr < na_rs + 8); }
        if (active) {
            const LAS unsigned char* kb = lds + cur * KB; const LAS unsigned char* vb = lds + VOFF + cur * VB;
            f32x16 p0, p1;
            if (NA) {
#pragma unroll
                for (int r = 0; r < 16; ++r) { p0[r] = 0.f; p1[r] = 0.f; }
            } else { p0 = negm; p1 = negm; }
            bf16x8 kf[8], vfr[8];
#pragma unroll
            for (int s = 0; s < 4; ++s) {
                kf[2 * s] = *(const LAS bf16x8*)(kb + q * 144 + (16 * s + 8 * h) * 2);
                kf[2 * s + 1] = *(const LAS bf16x8*)(kb + (q + 32) * 144 + (16 * s + 8 * h) * 2);
            }
#pragma unroll
            for (int s = 0; s < 4; ++s) {
                vfr[2 * s] = *(const LAS bf16x8*)(vb + q * 144 + 32 * s + 16 * h);
                vfr[2 * s + 1] = *(const LAS bf16x8*)(vb + (q + 32) * 144 + 32 * s + 16 * h);
            }
            __builtin_amdgcn_sched_barrier(0);
            __builtin_amdgcn_s_setprio(1);
#pragma unroll
            for (int s = 0; s < 4; ++s) {
                p0 = __builtin_amdgcn_mfma_f32_32x32x16_bf16(kf[2 * s], qb[s], p0, 0, 0, 0);
                p1 = __builtin_amdgcn_mfma_f32_32x32x16_bf16(kf[2 * s + 1], qb[s], p1, 0, 0, 0);
            }
            __builtin_amdgcn_s_setprio(0);
            if (NA) {
                if (j >= 4) {
                    const int dr = kr - na_r + 7, qc = na_qc0 + q;
#pragma unroll
                    for (int r = 0; r < 16; ++r) {
                        const int kc = 8 * (r >> 2) + 4 * h + (r & 3);
                        const bool v0 = (kc >= na_cs) && (kc < na_cs + 16), v1 = (kc + 32 >= na_cs) && (kc + 32 < na_cs + 16);
                        const int i0 = v0 ? dr * 31 + (kc - qc + 15) : 0, i1 = v1 ? dr * 31 + (kc + 32 - qc + 15) : 0;
                        const float b0 = biasL[i0], b1 = biasL[i1];
                        p0[r] = v0 ? p0[r] * qs + b0 - m : -INFINITY; p1[r] = v1 ? p1[r] * qs + b1 - m : -INFINITY;
                    }
                } else {
#pragma unroll
                    for (int r = 0; r < 16; ++r) { p0[r] = p0[r] * qs - m; p1[r] = p1[r] * qs - m; }
                }
            }
            float mx = fmaxf(fmaxf(p0[0], p1[0]), p0[1]), mx2 = fmaxf(fmaxf(p1[1], p0[2]), p1[2]);
#pragma unroll
            for (int r = 3; r < 15; r += 3) { mx = fmaxf(fmaxf(mx, p0[r]), p1[r]); mx2 = fmaxf(fmaxf(mx2, p0[r + 1]), p1[r + 1]); mx = fmaxf(fmaxf(mx, p0[r + 2]), p1[r + 2]); }
            mx = fmaxf(fmaxf(mx, mx2), fmaxf(p0[15], p1[15]));
            mx = xor32_max(mx);
            const bool need = (mx > 0.f) || (j == 0);
            if (__builtin_amdgcn_ballot_w64(need) != 0ull) {
                const float delta = need ? mx : 0.f;
                const float alpha = __builtin_amdgcn_exp2f(-delta);
                m += delta; l *= alpha;
#pragma unroll
                for (int r = 0; r < 16; ++r) { o0[r] *= alpha; o1[r] *= alpha; p0[r] -= delta; p1[r] -= delta; negm[r] = -m; }
            }
            float ls = 0.f;
#pragma unroll
            for (int r = 0; r < 16; ++r) { p0[r] = __builtin_amdgcn_exp2f(p0[r]); p1[r] = __builtin_amdgcn_exp2f(p1[r]); ls += p0[r] + p1[r]; }
            l += ls;
            bf16x8 pb[4];
            { u32x4 w;
              w.x = pk2(p0[0], p0[1]); w.y = pk2(p0[2], p0[3]); w.z = pk2(p0[4], p0[5]); w.w = pk2(p0[6], p0[7]); pb[0] = __builtin_bit_cast(bf16x8, w);
              w.x = pk2(p0[8], p0[9]); w.y = pk2(p0[10], p0[11]); w.z = pk2(p0[12], p0[13]); w.w = pk2(p0[14], p0[15]); pb[1] = __builtin_bit_cast(bf16x8, w);
              w.x = pk2(p1[0], p1[1]); w.y = pk2(p1[2], p1[3]); w.z = pk2(p1[4], p1[5]); w.w = pk2(p1[6], p1[7]); pb[2] = __builtin_bit_cast(bf16x8, w);
              w.x = pk2(p1[8], p1[9]); w.y = pk2(p1[10], p1[11]); w.z = pk2(p1[12], p1[13]); w.w = pk2(p1[14], p1[15]); pb[3] = __builtin_bit_cast(bf16x8, w); }
#pragma unroll
            for (int s = 0; s < 4; ++s) {
                const bf16x8 vf0 = vfr[2 * s], vf1 = vfr[2 * s + 1];
                o0 = __builtin_amdgcn_mfma_f32_32x32x16_bf16(vf0, pb[s], o0, 0, 0, 0);
                o1 = __builtin_amdgcn_mfma_f32_32x32x16_bf16(vf1, pb[s], o1, 0, 0, 0);
            }
        }
        if (j + 1 < ntiles) {
            *(LAS u32x4*)(lds + (cur ^ 1) * KB + srow * 144 + sch * 16) = kreg;
            LAS unsigned char* vp = lds + VOFF + (cur ^ 1) * VB + srow * 144 + (sch >> 1) * 32 + (sch & 1) * 8;
            *(LAS u32x2*)vp = (u32x2){vreg.x, vreg.y}; *(LAS u32x2*)(vp + 16) = (u32x2){vreg.z, vreg.w};
        }
        __syncthreads();
    }
    const float lt = xor32_sum(l), inv = 1.0f / lt;
    bf16_t* yp = Y + (size_t)(q_tok0 + q) * D + ycol + 4 * h;
#pragma unroll
    for (int g4 = 0; g4 < 4; ++g4) {
        u32x2 w0, w1;
        w0.x = pk2(o0[4 * g4] * inv, o0[4 * g4 + 1] * inv); w0.y = pk2(o0[4 * g4 + 2] * inv, o0[4 * g4 + 3] * inv);
        w1.x = pk2(o1[4 * g4] * inv, o1[4 * g4 + 1] * inv); w1.y = pk2(o1[4 * g4 + 2] * inv, o1[4 * g4 + 3] * inv);
        *(u32x2*)(yp + 8 * g4) = w0; *(u32x2*)(yp + 32 + 8 * g4) = w1;
    }
}

__device__ __forceinline__ void small_attn_phase(const Ctx& F, const Args& a, int l, int rep) {
    unsigned char* ws = a.ws;
    bf16_t* PB = (bf16_t*)(ws + WS_PB); bf16_t* Y = (bf16_t*)(ws + WS_Y);
    const bf16_t* VTA = (const bf16_t*)(ws + WS_VTA); const bf16_t* VTD = (const bf16_t*)(ws + WS_VTD);
    float* GS = (float*)(ws + WS_XN); const float* HA = (const float*)(ws + WS_HA);
    const int w = F.wave;
    const int nscan = F.G >= 128 ? 64 : 0;
    const int nwork = F.G - nscan;
    for (int it = (nscan ? F.bid - nwork : F.bid); rep == 0 && it >= 0 && it < 64; it += (nscan ? 64 : F.G)) {
        const int dh = it >> 3, dblk = it & 7, d = dblk * 8 + (F.tid >> 6), v = F.tid & 63;
        float S = 0.f;
        for (int c0 = 0; c0 < NCHUNK; c0 += 20) {
            float gq[20], aq[20];
#pragma unroll
            for (int j = 0; j < 20; ++j) { const size_t u = (size_t)((dh >> 2) * NCHUNK + c0 + j) * 4 + (dh & 3); gq[j] = GS[u * 4096 + d * 64 + v]; aq[j] = HA[u * 64 + d]; }
#pragma unroll
            for (int j = 0; j < 20; ++j) { const size_t u = (size_t)((dh >> 2) * NCHUNK + c0 + j) * 4 + (dh & 3); GS[u * 4096 + d * 64 + v] = S; S = aq[j] * S + gq[j]; }
        }
    }
    if (nscan && F.bid >= nwork) return;
    for (int u = F.bid; u < 256 + 8; u += nwork) {
        if (u < 256) {
            const int head = u & 3, rg = u >> 2, r = 4 * rg + (w >> 1);
            const int rs0 = min(max(4 * rg - 4, 0), 248), rs3 = min(max(4 * rg + 3 - 4, 0), 248);
            attn_unit<true>(F.lds, PB, VTD + (size_t)head * 64 * NTOK, Y, 64 * r + 32 * (w & 1), C_DQ + 64 * head, C_DK + 64 * head, 768 + 64 * head, 4 + (rs3 + 8 - rs0), 64 * rs0,
                            ATT_SCALE * LOG2E, r, rs0, 32 * (w & 1), in_ptr(18) + ((size_t)l * 4 + head) * 465, F.tid);
        } else if (u < 260) { const int uu = u - 256, kvh = uu & 1, t128 = uu >> 1, hq = 2 * kvh + (w >> 2);
            attn_unit<false>(F.lds, PB, VTA + (size_t)kvh * 64 * NTOK, Y, SEQ + t128 * 128 + 32 * (w & 3), C_AQ + 64 * hq, C_AK + 64 * kvh, 64 * hq, 4, 0, 1.0f, 0, 0, 0, nullptr, F.tid);
        } else { const int head = u - 260;
            attn_unit<true>(F.lds, PB, VTD + (size_t)head * 64 * NTOK, Y, SEQ + 32 * w, C_DQ + 64 * head, C_DK + 64 * head, 768 + 64 * head, 4, 0, ATT_SCALE * LOG2E, 0, 0, 0, in_ptr(18) + ((size_t)l * 4 + head) * 465, F.tid);
        }
    }
}
__device__ __forceinline__ void attn_phase(const Ctx& F, const Args& a, int l) {
    unsigned char* ws = a.ws;
    bf16_t* PB = (bf16_t*)(ws + WS_PB); bf16_t* Y = (bf16_t*)(ws + WS_Y);
    const bf16_t* VTA = (const bf16_t*)(ws + WS_VTA);
    const int w = F.wave;
    for (int u = F.bid; u < 256; u += F.G) {
        const int kvh = u & 1, t128 = u >> 1, hq = 2 * kvh + (w >> 2);
        attn_unit<false>(F.lds, PB, VTA + (size_t)kvh * 64 * NTOK, Y, t128 * 128 + 32 * (w & 3), C_AQ + 64 * hq, C_AK + 64 * kvh, 64 * hq, 4 + SEQ / 64, 0, 1.0f, 0, 0, 0, nullptr, F.tid);
    }
}

__device__ __forceinline__ void sum4_phase(const Ctx& F, const bf16_t* PB, bf16_t* MG) {
    for (int i = F.bid * 512 + F.tid; i < NTOK * 128; i += F.G * 512) {
        const int row = i >> 7, c8 = (i & 127) * 8;
        const bf16_t* zp = PB + (size_t)row * INW + C_GATE + c8;
        const u32x4 a = *(const u32x4*)zp, b = *(const u32x4*)(zp + 1024), c = *(const u32x4*)(zp + 2048), d = *(const u32x4*)(zp + 3072);
        u32x4 o;
        o.x = pk2((lo16(a.x) + lo16(b.x)) + (lo16(c.x) + lo16(d.x)), (hi16(a.x) + hi16(b.x)) + (hi16(c.x) + hi16(d.x)));
        o.y = pk2((lo16(a.y) + lo16(b.y)) + (lo16(c.y) + lo16(d.y)), (hi16(a.y) + hi16(b.y)) + (hi16(c.y) + hi16(d.y)));
        o.z = pk2((lo16(a.z) + lo16(b.z)) + (lo16(c.z) + lo16(d.z)), (hi16(a.z) + hi16(b.z)) + (hi16(c.z) + hi16(d.z)));
        o.w = pk2((lo16(a.w) + lo16(b.w)) + (lo16(c.w) + lo16(d.w)), (hi16(a.w) + hi16(b.w)) + (hi16(c.w) + hi16(d.w)));
        *(u32x4*)(MG + (size_t)row * D + c8) = o;
    }
}

__device__ __forceinline__ void hgrn_out_phase(const Ctx& F, const Args& a, int l) {
    unsigned char* ws = a.ws;
    const bf16_t* PB = (const bf16_t*)(ws + WS_PB); bf16_t* Y = (bf16_t*)(ws + WS_Y);
    const float* GS = (const float*)(ws + WS_XN);
    constexpr int WREG = 18432, TP = 144;
    const int lane = F.lane, dir = F.wave >> 2, wi = F.wave & 3, q_ = lane & 31, h = lane >> 5;
    LAS unsigned char* TQ = F.lds + F.wave * WREG;
    LAS unsigned char* TK = TQ + 9216;
    LAS float* ob = (LAS float*)TQ;
    const LAS float* ob_f = (const LAS float*)(F.lds + wi * WREG);
    const LAS float* ob_b = (const LAS float*)(F.lds + (wi + 4) * WREG);
    const float og = in_ptr(15)[l * 64 + lane];
    for (int it0 = 4 * F.bid; it0 < NCHUNK * 4; it0 += 4 * F.G) {
        const int it = it0 + wi;
        const int head = it & 3, jc = it >> 2;
        const int rb = jc < 256 ? 64 * jc : SEQ + 64 * (jc - 256);
        {
            const int c = dir == 0 ? (jc < 256 ? 4 + jc : jc - 256) : (jc < 256 ? 4 + 255 - jc : 3 - (jc - 256));
            const float lb = lb_val(in_ptr(14), l, dir, head * 64 + lane);
            const int colf = (dir ? C_BFB : C_BFF) + head * 64 + lane, colq = C_BQ + head * 64 + lane;
            float fv[64]; float ref = 0.f;
#pragma unroll
            for (int t = 0; t < 64; ++t) {
                const float pre = bf2f(PB[(size_t)(rb + (dir ? 63 - t : t)) * INW + colf]);
                const float f = lb + (1.0f - lb) * sigmoidf_(pre);
                fv[t] = f;
                if (t < 32) ref += __logf(f);
            }
            unsigned qh[32]; float cum = 0.f, qh_prev = 0.f;
#pragma unroll
            for (int t = 0; t < 64; ++t) {
                const float qv = bf2f(PB[(size_t)(rb + (dir ? 63 - t : t)) * INW + colq]) * 0.125f;
                cum += __logf(fv[t]);
                const float qt = qv * __expf(fminf(cum - ref, 80.f));
                const float kt = (1.0f - fv[t]) * __expf(fminf(ref - cum, 80.f));
                const float qhv = qv * __expf(cum);
                *(LAS bf16_t*)(TQ + t * TP + 2 * lane) = (bf16_t)f2bf(qt);
                *(LAS bf16_t*)(TK + t * TP + 2 * lane) = (bf16_t)f2bf(kt);
                if (t & 1) qh[t >> 1] = pk2(qh_prev, qhv); else qh_prev = qhv;
            }
            asm volatile("s_waitcnt lgkmcnt(0)" ::: "memory");
            __builtin_amdgcn_wave_barrier();
            f32x16 a00, a01, a11;
#pragma unroll
            for (int r = 0; r < 16; ++r) { a00[r] = 0.f; a01[r] = 0.f; a11[r] = 0.f; }
#pragma unroll
            for (int k = 0; k < 4; ++k) {
                const bf16x8 ka0 = *(const LAS bf16x8*)(TK + q_ * TP + (16 * k + 8 * h) * 2), ka1 = *(const LAS bf16x8*)(TK + (32 + q_) * TP + (16 * k + 8 * h) * 2);
                const bf16x8 qb0 = *(const LAS bf16x8*)(TQ + q_ * TP + (16 * k + 8 * h) * 2), qb1 = *(const LAS bf16x8*)(TQ + (32 + q_) * TP + (16 * k + 8 * h) * 2);
                a00 = __builtin_amdgcn_mfma_f32_32x32x16_bf16(ka0, qb0, a00, 0, 0, 0);
                a01 = __builtin_amdgcn_mfma_f32_32x32x16_bf16(ka0, qb1, a01, 0, 0, 0);
                a11 = __builtin_amdgcn_mfma_f32_32x32x16_bf16(ka1, qb1, a11, 0, 0, 0);
            }
#pragma unroll
            for (int r = 0; r < 16; ++r) { const bool ok = (8 * (r >> 2) + 4 * h + (r & 3)) <= q_; a00[r] = ok ? a00[r] : 0.f; a11[r] = ok ? a11[r] : 0.f; }
            bf16x8 p00[2], p01[2], p11[2];
#pragma unroll
            for (int k = 0; k < 2; ++k) { u32x4 w;
                w.x = pk2(a00[8 * k], a00[8 * k + 1]); w.y = pk2(a00[8 * k + 2], a00[8 * k + 3]); w.z = pk2(a00[8 * k + 4], a00[8 * k + 5]); w.w = pk2(a00[8 * k + 6], a00[8 * k + 7]); p00[k] = __builtin_bit_cast(bf16x8, w);
                w.x = pk2(a01[8 * k], a01[8 * k + 1]); w.y = pk2(a01[8 * k + 2], a01[8 * k + 3]); w.z = pk2(a01[8 * k + 4], a01[8 * k + 5]); w.w = pk2(a01[8 * k + 6], a01[8 * k + 7]); p01[k] = __builtin_bit_cast(bf16x8, w);
                w.x = pk2(a11[8 * k], a11[8 * k + 1]); w.y = pk2(a11[8 * k + 2], a11[8 * k + 3]); w.z = pk2(a11[8 * k + 4], a11[8 * k + 5]); w.w = pk2(a11[8 * k + 6], a11[8 * k + 7]); p11[k] = __builtin_bit_cast(bf16x8, w); }
            asm volatile("s_waitcnt lgkmcnt(0)" ::: "memory");
            __builtin_amdgcn_wave_barrier();
#pragma unroll
            for (int t2 = 0; t2 < 32; ++t2) { *(LAS bf16_t*)(TQ + (2 * t2) * TP + 2 * lane) = (bf16_t)(qh[t2] & 0xffffu); *(LAS bf16_t*)(TQ + (2 * t2 + 1) * TP + 2 * lane) = (bf16_t)(qh[t2] >> 16); }
            f32x16 o[2][2];
#pragma unroll
            for (int r = 0; r < 16; ++r) { o[0][0][r] = 0.f; o[0][1][r] = 0.f; o[1][0][r] = 0.f; o[1][1][r] = 0.f; }
            const bf16_t* vbase = PB + C_BI + head * 64 + q_;
#pragma unroll
            for (int cv = 0; cv < 2; ++cv)
#pragma unroll
                for (int sa = 0; sa < 2; ++sa)
#pragma unroll
                    for (int k = 0; k < 2; ++k) {
                        unsigned e[8];
#pragma unroll
                        for (int j = 0; j < 8; ++j) { const int s = 32 * sa + 16 * k + 8 * (j >> 2) + 4 * h + (j & 3); e[j] = vbase[(size_t)(rb + (dir ? 63 - s : s)) * INW + 32 * cv]; }
                        const u32x4 w = {e[0] | (e[1] << 16), e[2] | (e[3] << 16), e[4] | (e[5] << 16), e[6] | (e[7] << 16)};
                        const bf16x8 vf = __builtin_bit_cast(bf16x8, w);
                        if (sa == 0) { o[cv][0] = __builtin_amdgcn_mfma_f32_32x32x16_bf16(vf, p00[k], o[cv][0], 0, 0, 0); o[cv][1] = __builtin_amdgcn_mfma_f32_32x32x16_bf16(vf, p01[k], o[cv][1], 0, 0, 0); }
                        else o[cv][1] = __builtin_amdgcn_mfma_f32_32x32x16_bf16(vf, p11[k], o[cv][1], 0, 0, 0);
                    }
            asm volatile("s_waitcnt lgkmcnt(0)" ::: "memory");
            __builtin_amdgcn_wave_barrier();
            const float* sbase = GS + ((size_t)((dir * NCHUNK + c) * 4 + head)) * 4096 + q_;
#pragma unroll
            for (int cv = 0; cv < 2; ++cv)
#pragma unroll
                for (int k = 0; k < 4; ++k) {
                    float sv[8];
#pragma unroll
                    for (int j = 0; j < 8; ++j) sv[j] = sbase[(16 * k + 8 * h + j) * 64 + 32 * cv];
                    const u32x4 w = {pk2(sv[0], sv[1]), pk2(sv[2], sv[3]), pk2(sv[4], sv[5]), pk2(sv[6], sv[7])};
                    const bf16x8 sf = __builtin_bit_cast(bf16x8, w);
                    const bf16x8 qb0 = *(const LAS bf16x8*)(TQ + q_ * TP + (16 * k + 8 * h) * 2), qb1 = *(const LAS bf16x8*)(TQ + (32 + q_) * TP + (16 * k + 8 * h) * 2);
                    o[cv][0] = __builtin_amdgcn_mfma_f32_32x32x16_bf16(sf, qb0, o[cv][0], 0, 0, 0);
                    o[cv][1] = __builtin_amdgcn_mfma_f32_32x32x16_bf16(sf, qb1, o[cv][1], 0, 0, 0);
                }
            asm volatile("s_waitcnt lgkmcnt(0)" ::: "memory");
            __builtin_amdgcn_wave_barrier();
#pragma unroll
            for (int cv = 0; cv < 2; ++cv)
#pragma unroll
                for (int tb = 0; tb < 2; ++tb) {
                    const int t = 32 * tb + q_, tt = dir ? 63 - t : t;
#pragma unroll
                    for (int g4 = 0; g4 < 4; ++g4)
                        *(LAS f32x4*)(ob + tt * 64 + 32 * cv + 8 * g4 + 4 * h) = (f32x4){o[cv][tb][4 * g4], o[cv][tb][4 * g4 + 1], o[cv][tb][4 * g4 + 2], o[cv][tb][4 * g4 + 3]};
                }
        }
        __syncthreads();
        {
#pragma unroll 4
            for (int k = 0; k < 32; ++k) {
                const int tt = 32 * dir + k;
                const float ot = ob_f[tt * 64 + lane] + ob_b[tt * 64 + lane];
                const float ss = wave_sum(ot * ot);
                const float gg = bf2f(PB[(size_t)(rb + tt) * INW + C_BG + head * 64 + lane]);
                const float y = ot * (1.0f / sqrtf(ss * (1.f / 64.f) + EPSN)) * og * siluf_(gg);
                Y[(size_t)(rb + tt) * D + 256 + head * 64 + lane] = (bf16_t)f2bf(y);
            }
        }
        __syncthreads();
    }
}

#define XB_TMO      128
#define XB_XCNT(j)  (256  + 64 * (j))
#define XB_XSUB(j)  (1280 + 64 * (j))
#define XB_XGEN(j)  (2304 + 64 * (j))
#define XB_TOP      3328
#define XB_TOPGEN   3392
#define XCD_BAR_WORDS 3456
#define XB_SPIN_CAP (1u << 18)

__device__ __forceinline__ unsigned xb_ld(unsigned* p)              { return __hip_atomic_load(p, __ATOMIC_RELAXED, __HIP_MEMORY_SCOPE_AGENT); }
__device__ __forceinline__ unsigned xb_add(unsigned* p, unsigned v) { return __hip_atomic_fetch_add(p, v, __ATOMIC_RELAXED, __HIP_MEMORY_SCOPE_AGENT); }
__device__ __forceinline__ unsigned xb_xcc_id() { return (unsigned)__builtin_amdgcn_s_getreg((3 << 11) | 20) & 0xFu; }
#define XB_SPIN(cond, bar) do { unsigned _sp = 0; while (cond) { __builtin_amdgcn_s_sleep(1); \
    if ((++_sp & 255u) == 0u) { if (xb_ld(&(bar)[XB_TMO])) break; if (_sp > XB_SPIN_CAP) { atomicAdd(&(bar)[XB_TMO], 1u); break; } } } } while (0)

struct XcdBarrier {
    unsigned* bar; unsigned x;
    volatile LAS unsigned* st;
};

__device__ __forceinline__ XcdBarrier xcd_barrier_post(unsigned* bar, volatile LAS unsigned* st) {
    XcdBarrier b; b.bar = bar; b.x = xb_xcc_id(); b.st = st;
    if (threadIdx.x == 0) (void)xb_add(&bar[XB_XCNT(b.x)], 1u);
    return b;
}
__device__ __forceinline__ void xcd_barrier_complete(unsigned* bar, unsigned x, unsigned& nloc, unsigned& nx) {
    const unsigned G = gridDim.x * gridDim.y * gridDim.z;
    unsigned sum, cnt, mine, sp = 0u;
    for (;;) {
        sum = 0u; cnt = 0u; mine = 0u;
#pragma unroll
        for (unsigned j = 0; j < 16; ++j) { const unsigned c = xb_ld(&bar[XB_XCNT(j)]); sum += c; cnt += (c > 0u) ? 1u : 0u; mine = (j == x) ? c : mine; }
        if (sum == G) break;
        __builtin_amdgcn_s_sleep(1);
        if ((++sp & 255u) == 0u) { if (xb_ld(&bar[XB_TMO])) break; if (sp > XB_SPIN_CAP) { atomicAdd(&bar[XB_TMO], 1u); break; } }
    }
    nloc = mine > 0u ? mine : 1u; nx = cnt > 0u ? cnt : 1u;
}

__device__ __forceinline__ void xcd_barrier(const XcdBarrier& b) {
    asm volatile("s_waitcnt vmcnt(0)" ::: "memory");
    __syncthreads();
    if (threadIdx.x == 0) {
        unsigned* bar = b.bar;
        __builtin_amdgcn_s_waitcnt(0);
        unsigned nloc = b.st[0], nx = b.st[1];
        if (nloc == 0u) { xcd_barrier_complete(bar, b.x, nloc, nx); b.st[0] = nloc; b.st[1] = nx; }
        const unsigned old = xb_add(&bar[XB_XSUB(b.x)], 1u);
        const unsigned gen = old / nloc;
        if (old + 1u == (gen + 1u) * nloc) {
            __builtin_amdgcn_fence(__ATOMIC_RELEASE, "agent");
            asm volatile("s_waitcnt vmcnt(0)" ::: "memory");
            const unsigned og = xb_add(&bar[XB_TOP], 1u);
            const unsigned tg = og / nx;
            if (og + 1u == (tg + 1u) * nx) xb_add(&bar[XB_TOPGEN], 1u);
            else XB_SPIN(xb_ld(&bar[XB_TOPGEN]) == tg, bar);
            __builtin_amdgcn_fence(__ATOMIC_ACQUIRE, "agent");
            xb_add(&bar[XB_XGEN(b.x)], 1u);
            asm volatile("s_waitcnt vmcnt(0)" ::: "memory");
        } else {
            XB_SPIN(xb_ld(&bar[XB_XGEN(b.x)]) == gen, bar);
            __builtin_amdgcn_fence(__ATOMIC_ACQUIRE, "agent");
            asm volatile("s_waitcnt vmcnt(0)" ::: "memory");
        }
    }
    __syncthreads();
}

__device__ __forceinline__ Ctx relaunder(Ctx F) {
    int t = F.tid; asm volatile("" : "+v"(t));
    F.tid = t; F.lane = t & 63; F.wave = __builtin_amdgcn_readfirstlane(t >> 6); F.gw = F.bid * 8 + F.wave;
    return F;
}
__global__ void __launch_bounds__(512, 2) mk_fwd(Args args) {
    extern __shared__ __attribute__((aligned(16))) unsigned char lds_raw[];
    cg::grid_group grid = cg::this_grid();
    unsigned char* ws = args.ws;
    float* X = (float*)(ws + WS_X); bf16_t* XN = (bf16_t*)(ws + WS_XN); bf16_t* PB = (bf16_t*)(ws + WS_PB); bf16_t* Y = (bf16_t*)(ws + WS_Y);
    const int wave0 = __builtin_amdgcn_readfirstlane(threadIdx.x >> 6);
    volatile LAS unsigned* bar_st = (volatile LAS unsigned*)((LAS unsigned char*)lds_raw + (LDS_BYTES - 256));
    if (threadIdx.x < 2) bar_st[threadIdx.x] = 0u;
    __syncthreads();
    const XcdBarrier xbar = xcd_barrier_post((unsigned*)args.ws, bar_st);
    for (int ph = args.ph_lo; ph < args.ph_hi; ++ph) {
        unsigned z_; asm volatile("v_mov_b32 %0, 0" : "=v"(z_));
        const int lane_ = (int)__builtin_amdgcn_mbcnt_hi(~0u, __builtin_amdgcn_mbcnt_lo(~0u, z_)); int bid_ = blockIdx.x;
        asm volatile("" : "+s"(bid_));
        const int tid_ = wave0 * 64 + lane_;
        Ctx F0;
        F0.lds = (LAS unsigned char*)lds_raw;
        F0.tid = tid_; F0.lane = F0.tid & 63; F0.wave = wave0;
        F0.G = gridDim.x; F0.bid = bid_; F0.gw = F0.bid * 8 + F0.wave; F0.ngw = F0.G * 8;
        int nrep = 1;
        if (PROBE_DBL) { const int sp_ = (ph - 1) % NSUB;
            if (ph == 0) nrep = (PROBE_DBL & 1) ? 2 : 1;
            else if (ph == NPHASE - 1) nrep = (PROBE_DBL & 64) ? 2 : 1;
            else if (sp_ == 0 || sp_ == 3 || sp_ == 11) nrep = (PROBE_DBL & 2) ? 2 : 1;
            else if (sp_ == 1 || sp_ == 12) nrep = (PROBE_DBL & 4) ? 2 : 1;
            else if (sp_ == 4) nrep = (PROBE_DBL & 8) ? 2 : 1;
            else if (sp_ == 2 || sp_ == 13) nrep = (PROBE_DBL & 1024) ? 2 : 1;
            else if (sp_ == 10) nrep = (PROBE_DBL & 2048) ? 2 : 1;
            else if (sp_ == 5) nrep = (PROBE_DBL & 256) ? 2 : 1;
            else if (sp_ == 6) nrep = (PROBE_DBL & 512) ? 2 : 1;
            else if (sp_ == 7) nrep = (PROBE_DBL & 16) ? 2 : 1;
            }
        for (int rep = 0; rep < nrep; ++rep) {
        if (ph == 0) { if (PHM & 1) { const Ctx F = relaunder(F0); phase0(F, args); } }
        else if (ph == NPHASE - 1) { if (PHM & 2) { const Ctx F = relaunder(F0); final_norm_phase(F, X, in_ptr(25), args.out); } }
        else {
            const int l = (ph - 1) / NSUB, sp = (ph - 1) % NSUB;
            const float* modl = (const float*)(ws + WS_MOD) + (size_t)l * 2 * NMODV;
            const bf16_t* WL = (const bf16_t*)(ws + WS_W) + (size_t)l * LAYER_W;
            if ((PHM & 4) && sp == 0) { const Ctx F = relaunder(F0); norm_phase(F, X, in_ptr(6) + l * D, modl, 0, 1, XN, (const float*)(ws + WS_PART), l > 0 ? 11 : 0); }
            else if ((PHM & 4) && sp == 3) { const Ctx F = relaunder(F0); norm_phase(F, X, in_ptr(10) + l * D, modl, 3, 4, XN, (const float*)(ws + WS_PART), 11); }
            else if ((PHM & 4) && sp == 11) { const Ctx F = relaunder(F0); norm_phase(F, X, in_ptr(21) + l * D, modl, 6, 7, XN, (const float*)(ws + WS_PART), 8); }
            else if ((PHM & 8) && (sp == 1 || sp == 12)) {
                const Ctx F = relaunder(F0);
                pg8::Gemm g{XN, WL + (sp == 1 ? O_WGU1 : O_WGU2), NTOK, 2 * DFF, D, D, 30, 0}; pg8::StaticOrder S; S.init(NTOK, 2 * DFF, D, F.G, F.bid);
                pg8::EpiSwiglu E{PB};
                pg8::gemm_phase<pg8::EpiSwiglu, pg8::StaticOrder>(F.lds, g, S, E, F.tid);
            } else if ((PHM & 16) && (sp == 2 || sp == 13)) {
                const Ctx F = relaunder(F0);
                pg8::Gemm g{PB, WL + (sp == 2 ? O_WD1 : O_WD2), NTOK, D, DFF, DFF, 30, 0}; pg8::ResidOrder S; S.init(DFF, 11, F.G, F.bid);
                pg8::EpiResid E{X, modl, sp == 2 ? 2 : 8, rep == 0 ? 0.5f : 0.0f, DFF / 64, (float*)(ws + WS_PART), 2};
                pg8::gemm_phase<pg8::EpiResid, pg8::ResidOrder>(F.lds, g, S, E, F.tid);
            } else if ((PHM & 32) && sp == 4) {
                const Ctx F = relaunder(F0);
                pg8::Gemm g{XN, WL + O_WIN, NTOK, INW, D, D, 30, 0}; pg8::StaticOrder S; S.init(NTOK, INW, D, F.G, F.bid);
                pg8::EpiPlain E{PB, INW};
                pg8::gemm_phase<pg8::EpiPlain, pg8::StaticOrder>(F.lds, g, S, E, F.tid);
            } else if ((PHM & 64) && sp == 5) { { const Ctx F = relaunder(F0); prep_h1_phase(F.lds, ws, in_ptr(14), l, F.tid, F.bid, F.G); } { const Ctx F = relaunder(F0); prep_pool_phase(F, args, l); } { const Ctx F = relaunder(F0); prep_qkv_phase(F, args, l, rep); } }
            else if ((PHM & 128) && sp == 6) { const Ctx F = relaunder(F0); small_attn_phase(F, args, l, rep); }
            else if ((PHM & 128) && sp == 7) {
                { const Ctx F = relaunder(F0); attn_phase(F, args, l); }
                __syncthreads();
                if (PHM & 256) { const Ctx F = relaunder(F0); hgrn_out_phase(F, args, l); }
            }
            else if ((PHM & 512) && sp == 8) {
                const Ctx F = relaunder(F0);
                pg8::Gemm g{Y, WL + O_WB, NTOK, 4096, 256, D, 2, 512}; pg8::StaticOrder S; S.init(NTOK, 4096, 256, F.G, F.bid);
                pg8::EpiGate E{PB + C_GATE, INW};
                pg8::gemm_phase<pg8::EpiGate, pg8::StaticOrder>(F.lds, g, S, E, F.tid);
            } else if ((PHM & 1024) && sp == 9) { const Ctx F = relaunder(F0); sum4_phase(F, PB, XN); }
            else if ((PHM & 1024) && sp == 10) {
                const Ctx F = relaunder(F0);
                pg8::Gemm g{XN, WL + O_WO4, NTOK, D, D, D, 30, 0}; pg8::ResidOrder S; S.init(D, 8, F.G, F.bid);
                pg8::EpiResid E{X, modl, 5, rep == 0 ? 1.0f : 0.0f, D / 64, (float*)(ws + WS_PART), 1};
                pg8::gemm_phase<pg8::EpiResid, pg8::ResidOrder>(F.lds, g, S, E, F.tid);
            }
        }
        }
        if (ph + 1 < args.ph_hi) { if (ph == 0) grid.sync(); else xcd_barrier(xbar); if (PROBE_DBL & 128) xcd_barrier(xbar); }
    }
}

extern "C" void kernel_launch(void* const* d_in, const int* in_sizes, int n_in, void* d_out, int out_size, void* d_ws, size_t ws_size, hipStream_t stream) {
    static int grid = 0;
    if (grid == 0) {
        if (n_in != 26 || in_sizes[0] != SEQ * D || out_size != SEQ * D || ws_size < WS_END) {
            fprintf(stderr, "kernel_launch: unexpected shapes (n_in %d, in0 %d, out %d, ws %zu, need %zu); nothing launched\n", n_in, n_in > 0 ? in_sizes[0] : -1, out_size, ws_size, (size_t)WS_END); grid = -1; return; }
        int dev = 0, cus = 0, per_cu = 0;
        hipGetDevice(&dev); hipDeviceGetAttribute(&cus, hipDeviceAttributeMultiprocessorCount, dev);
        if (hipFuncSetAttribute((const void*)mk_fwd, hipFuncAttributeMaxDynamicSharedMemorySize, LDS_BYTES) != hipSuccess) { fprintf(stderr, "kernel_launch: hipFuncSetAttribute failed\n"); grid = -1; return; }
        if (hipOccupancyMaxActiveBlocksPerMultiprocessor(&per_cu, (const void*)mk_fwd, 512, LDS_BYTES) != hipSuccess || per_cu < 1) { fprintf(stderr, "kernel_launch: occupancy query says %d blocks per CU\n", per_cu); per_cu = 1; }
        (void)hipGetLastError();
        grid = cus * (per_cu > 1 ? 1 : per_cu);
        if (grid <= 0) grid = 256;
    }
    if (grid < 0) return;
    if (hipMemsetAsync(d_ws, 0, 16384, stream) != hipSuccess) { fprintf(stderr, "kernel_launch: hipMemsetAsync failed\n"); return; }
    Args a{};
    for (int i = 0; i < 26; ++i) a.in[i] = (const float*)d_in[i];
    a.out = (float*)d_out; a.ws = (unsigned char*)d_ws;
#if MK_PER_PHASE
    for (int ph = 0; ph < NPHASE; ++ph) { a.ph_lo = ph; a.ph_hi = ph + 1; hipLaunchKernelGGL(mk_fwd, dim3(grid), dim3(512), LDS_BYTES, stream, a); }
#else
    a.ph_lo = 0; a.ph_hi = NPHASE;
    void* kargs[] = {&a};
    hipError_t e = hipLaunchCooperativeKernel((const void*)mk_fwd, dim3(grid), dim3(512), kargs, LDS_BYTES, stream);
    if (e != hipSuccess) fprintf(stderr, "kernel_launch: cooperative launch failed: %s (grid %d)\n", hipGetErrorString(e), grid);
#endif
}
```

```cpp
#include <hip/hip_runtime.h>
#include <hip/hip_cooperative_groups.h>
#include <cstdio>
#include <cstdint>
namespace cg = cooperative_groups;

#ifndef MK_PER_PHASE
#define MK_PER_PHASE 0
#endif

#ifndef PROBE_DBL
#define PROBE_DBL 0
#endif
#ifndef PHM
#define PHM 0xffff
#endif
#define LAS __attribute__((address_space(3)))
typedef unsigned short bf16_t;
typedef short bf16x8 __attribute__((ext_vector_type(8)));
typedef short s16x4 __attribute__((ext_vector_type(4)));
typedef float f32x4 __attribute__((ext_vector_type(4)));
typedef float f32x16 __attribute__((ext_vector_type(16)));
typedef unsigned u32x4 __attribute__((ext_vector_type(4)));
typedef unsigned u32x2 __attribute__((ext_vector_type(2)));

constexpr int D = 1024, SEQ = 16384, CTX = 256, NTOK = SEQ + CTX, DEPTH = 4, DFF = 2816, INW = 6912, NMODV = 9 * 1024;
constexpr int C_AQ = 0, C_AK = 256, C_AV = 384, C_BQ = 512, C_BFF = 768, C_BFB = 1024, C_BI = 1280, C_BG = 1536, C_CX = 1792, C_DQ = 2048, C_DK = 2304, C_DV = 2560, C_GATE = 2816;
constexpr int NCHUNK = NTOK / 64;
constexpr float EPSN = 1e-6f;
constexpr float LOG2E = 1.4426950408889634f;
constexpr float ATT_SCALE = 0.125f;

constexpr size_t O_WGU1 = 0, O_WD1 = O_WGU1 + (size_t)2 * DFF * D, O_WIN = O_WD1 + (size_t)D * DFF, O_WB = O_WIN + (size_t)INW * D, O_WO4 = O_WB + (size_t)4096 * 256,
                 O_WGU2 = O_WO4 + (size_t)1024 * 1024, O_WD2 = O_WGU2 + (size_t)2 * DFF * D, LAYER_W = O_WD2 + (size_t)D * DFF;
constexpr size_t WS_W = 1u << 20;
constexpr size_t WS_MOD = WS_W + LAYER_W * 2 * DEPTH;
constexpr size_t WS_X = WS_MOD + (size_t)DEPTH * 2 * NMODV * 4 + 1024;
constexpr size_t WS_XN = WS_X + (size_t)NTOK * D * 4;
constexpr size_t WS_HA = WS_XN + (size_t)NTOK * D * 2;
constexpr size_t WS_PB = WS_HA + (size_t)2 * NCHUNK * 4 * 64 * 4;
constexpr size_t WS_Y = WS_PB + (size_t)NTOK * INW * 2;
constexpr size_t WS_VTA = WS_Y + (size_t)NTOK * D * 2;
constexpr size_t WS_VTD = WS_VTA + (size_t)2 * 64 * NTOK * 2;
constexpr size_t WS_PART = WS_VTD + (size_t)4 * 64 * NTOK * 2;
constexpr size_t WS_END = WS_PART + (size_t)11 * 256 * 1024 * 4;
static_assert(WS_X % 256 == 0 && WS_XN % 256 == 0 && WS_PB % 256 == 0 && WS_Y % 256 == 0 && WS_VTA % 256 == 0, "ws align");
static_assert((size_t)2 * NCHUNK * 4 * 4096 * 4 <= (size_t)NTOK * D * 2, "GS overlay fits XN");

constexpr int LDS_BYTES = 148480;
constexpr int NSUB = 14;
constexpr int NPHASE = 1 + NSUB * DEPTH + 1;

__device__ __forceinline__ float bf2f(unsigned v) { return __uint_as_float(v << 16); }
typedef __bf16 bf16x2_t __attribute__((ext_vector_type(2)));
typedef float f32x2_t __attribute__((ext_vector_type(2)));
__device__ __forceinline__ unsigned pk2(float lo, float hi) { const f32x2_t v = {lo, hi}; const bf16x2_t b = __builtin_convertvector(v, bf16x2_t); return __builtin_bit_cast(unsigned, b); }
__device__ __forceinline__ unsigned f2bf(float f) { return pk2(f, 0.f) & 0xffffu; }
__device__ __forceinline__ float lo16(unsigned w) { return __uint_as_float(w << 16); }
__device__ __forceinline__ float hi16(unsigned w) { return __uint_as_float(w & 0xffff0000u); }
__device__ __forceinline__ float max3f(float a, float b, float c) { float r; asm("v_max3_f32 %0, %1, %2, %3" : "=v"(r) : "v"(a), "v"(b), "v"(c)); return r; }
template <int K> __device__ __forceinline__ float swz_xor(float v) { return __uint_as_float((unsigned)__builtin_amdgcn_ds_swizzle((int)__float_as_uint(v), (K << 10) | 0x1f)); }
__device__ __forceinline__ float xor32_sum(float v) { const auto rr = __builtin_amdgcn_permlane32_swap(__float_as_uint(v), __float_as_uint(v), false, false); return __uint_as_float(rr[0]) + __uint_as_float(rr[1]); }
__device__ __forceinline__ float xor32_max(float v) { const auto rr = __builtin_amdgcn_permlane32_swap(__float_as_uint(v), __float_as_uint(v), false, false); return fmaxf(__uint_as_float(rr[0]), __uint_as_float(rr[1])); }
__device__ __forceinline__ float wave_sum(float v) {
    v += swz_xor<1>(v); v += swz_xor<2>(v); v += swz_xor<4>(v); v += swz_xor<8>(v); v += swz_xor<16>(v);
    return xor32_sum(v);
}
__device__ __forceinline__ float sigmoidf_(float x) { return __builtin_amdgcn_rcpf(1.0f + __builtin_amdgcn_exp2f(-1.4426950408889634f * x)); }
__device__ __forceinline__ float siluf_(float x) { return x * __builtin_amdgcn_rcpf(1.0f + __builtin_amdgcn_exp2f(-1.4426950408889634f * x)); }

__device__ __forceinline__ void fadd_agent(float* p, float v) { (void)__hip_atomic_fetch_add(p, v, __ATOMIC_RELAXED, __HIP_MEMORY_SCOPE_AGENT); }

namespace pg8 {
constexpr int BM = 256, BK = 64, HALF = 128, HTB = HALF * BK * 2, STAGE_BYTES = 8 * HTB, NXCD = 8, WGM = 8;
__host__ __device__ __forceinline__ int lds_byte(int r, int c) { const int st = (r >> 4) * 2 + (c >> 5), rr = r & 15, cc = c & 31, ob = rr * 64 + cc * 2; return st * 1024 + (ob ^ (((ob >> 9) & 1) << 5)); }
__host__ __device__ __forceinline__ void stage_rc(int b, int& R, int& C) { const int st = b / 1024, sb = b % 1024, swz = sb ^ (((sb >> 9) & 1) << 5); R = (st >> 1) * 16 + swz / 64; C = (st & 1) * 32 + (swz % 64) / 2; }
__host__ __device__ __forceinline__ int perm32(int rho) { const int n = rho >> 4, i = rho & 15; return 8 * (i >> 2) + 4 * n + (i & 3); }

struct Unit { int pm, pn, kt0, nkt; };
struct Gemm { const bf16_t* A; const bf16_t* Bt; int M, N, K, lda, a_sh, a_str; };

struct StaticOrder {
    int nM, nN, nwg, G, c, nkt;
    __host__ __device__ void init(int M, int N, int K, int G_, int c_) { nM = M / BM; nN = N / BM; nwg = nM * nN; G = G_; c = c_; nkt = K / BK; }
    __host__ __device__ bool next(int i, Unit& u) const {
        const long L = (long)i * G + c; if (L >= nwg) return false;
        int wgid = (int)L; { const int q = nwg / NXCD, r = nwg % NXCD, xcd = wgid % NXCD, off = wgid / NXCD; wgid = (xcd < r ? xcd * (q + 1) : r * (q + 1) + (xcd - r) * q) + off; }
        const int nig = WGM * nN, gid = wgid / nig, fm = gid * WGM, gsz = (nM - fm) < WGM ? (nM - fm) : WGM;
        u.pm = fm + ((wgid % nig) % gsz); u.pn = (wgid % nig) / gsz; u.kt0 = 0; u.nkt = nkt; return true;
    }
};
struct ResidOrder {
    int G, c, nkt, ksplit;
    __host__ __device__ void init(int K, int ksplit_, int G_, int c_) { G = G_; c = c_; nkt = K / BK; ksplit = ksplit_; }
    __host__ __device__ bool next(int i, Unit& u) const {
        const long L = (long)i * G + c;
        const bool lat = L < 256; const int Lc = (int)L - 256;
        int wgid = (int)(L & 255); wgid = (wgid % NXCD) * (256 / NXCD) + wgid / NXCD;
        const int nig = WGM * 4, fm = (wgid / nig) * WGM;
        const int pm_l = fm + ((wgid % nig) % WGM), pn_l = (wgid % nig) / WGM, nk_s = nkt / ksplit;
        u.pm = lat ? pm_l : SEQ / BM; u.pn = lat ? pn_l : (Lc & 3); u.nkt = lat ? nkt : nk_s; u.kt0 = lat ? 0 : (Lc >> 2) * nk_s;
        return lat || (Lc < 4 * ksplit);
    }
};


struct EpiSwiglu {
    static constexpr bool PERM = false;
    bf16_t* H;
    __device__ __forceinline__ void operator()(const f32x4 (&acc)[2][2][4][2], const Unit& u, int wr, int wc, int fr, int fq) const {
        const int row0 = u.pm * BM + wr * 64 + fr;
#pragma unroll
        for (int ai = 0; ai < 2; ++ai)
#pragma unroll
            for (int m = 0; m < 4; ++m) {
                bf16_t* rowp = H + (size_t)(row0 + ai * HALF + m * 16) * DFF;
#pragma unroll
                for (int bj = 0; bj < 2; ++bj) {
                    const int hid = (u.pn * 8 + bj * 4 + wc) * 16 + 4 * fq;
                    const f32x4 g = acc[ai][bj][m][0], up = acc[ai][bj][m][1];
                    u32x2 w; w.x = pk2(siluf_(g[0]) * up[0], siluf_(g[1]) * up[1]); w.y = pk2(siluf_(g[2]) * up[2], siluf_(g[3]) * up[3]);
                    *(u32x2*)(rowp + hid) = w;
                }
            }
    }
};
struct EpiResid {
    static constexpr bool PERM = false;
    float* X; const float* modl; int sel; float coef; int nkt_full; float* part; int ksh;
    __device__ __forceinline__ void operator()(const f32x4 (&acc)[2][2][4][2], const Unit& u, int wr, int wc, int fr, int fq) const {
        const float* mv = modl + (u.pm == (SEQ / BM) ? NMODV : 0) + sel * 1024;
        const int col0 = u.pn * BM + wc * 32 + 4 * fq;
        const bool split = u.nkt != nkt_full;
        float* base = split ? part + ((ptrdiff_t)(u.kt0 >> ksh) * 256 - (ptrdiff_t)u.pm * BM) * D : X;
#pragma unroll
        for (int bj = 0; bj < 2; ++bj)
#pragma unroll
            for (int n = 0; n < 2; ++n) {
                const f32x4 gv = *(const f32x4*)(mv + col0 + bj * HALF + n * 16) * coef;
#pragma unroll
                for (int ai = 0; ai < 2; ++ai)
#pragma unroll
                    for (int m = 0; m < 4; ++m) {
                        float* p = base + (size_t)(u.pm * BM + ai * HALF + wr * 64 + m * 16 + fr) * D + col0 + bj * HALF + n * 16;
                        const f32x4 dv = gv * acc[ai][bj][m][n];
                        if (split) *(f32x4*)p = dv;
                        else { const f32x4 xo = *(const f32x4*)p; *(f32x4*)p = xo + dv; }
                    }
            }
    }
};
struct EpiPlain {
    static constexpr bool PERM = true;
    bf16_t* O; int ldc;
    __device__ __forceinline__ void operator()(const f32x4 (&acc)[2][2][4][2], const Unit& u, int wr, int wc, int fr, int fq) const {
        const int row0 = u.pm * BM + wr * 64 + fr, col0 = u.pn * BM + wc * 32 + 8 * fq;
#pragma unroll
        for (int ai = 0; ai < 2; ++ai)
#pragma unroll
            for (int m = 0; m < 4; ++m) {
                bf16_t* rowp = O + (size_t)(row0 + ai * HALF + m * 16) * ldc + col0;
#pragma unroll
                for (int bj = 0; bj < 2; ++bj) {
                    const f32x4 v0 = acc[ai][bj][m][0], v1 = acc[ai][bj][m][1];
                    u32x4 w; w.x = pk2(v0[0], v0[1]); w.y = pk2(v0[2], v0[3]); w.z = pk2(v1[0], v1[1]); w.w = pk2(v1[2], v1[3]);
                    *(u32x4*)(rowp + bj * HALF) = w;
                }
            }
    }
};
struct EpiGate {
    static constexpr bool PERM = true;
    bf16_t* O; int ldc;
    __device__ __forceinline__ void operator()(const f32x4 (&acc)[2][2][4][2], const Unit& u, int wr, int wc, int fr, int fq) const {
        const int row0 = u.pm * BM + wr * 64 + fr, col0 = u.pn * BM + wc * 32 + 8 * fq;
#pragma unroll
        for (int ai = 0; ai < 2; ++ai)
#pragma unroll
            for (int m = 0; m < 4; ++m) {
                bf16_t* rowp = O + (size_t)(row0 + ai * HALF + m * 16) * ldc + col0;
#pragma unroll
                for (int bj = 0; bj < 2; ++bj) {
                    u32x4 gp = *(const u32x4*)(rowp + bj * HALF);
                    const f32x4 v0 = acc[ai][bj][m][0], v1 = acc[ai][bj][m][1];
                    gp.x = pk2(sigmoidf_(lo16(gp.x)) * v0[0], sigmoidf_(hi16(gp.x)) * v0[1]); gp.y = pk2(sigmoidf_(lo16(gp.y)) * v0[2], sigmoidf_(hi16(gp.y)) * v0[3]);
                    gp.z = pk2(sigmoidf_(lo16(gp.z)) * v1[0], sigmoidf_(hi16(gp.z)) * v1[1]); gp.w = pk2(sigmoidf_(lo16(gp.w)) * v1[2], sigmoidf_(hi16(gp.w)) * v1[3]);
                    *(u32x4*)(rowp + bj * HALF) = gp;
                    asm volatile("" ::: "memory");
                }
            }
    }
};

struct ZOrder {
    int G, c, nch4;
    __host__ __device__ void init(int G_, int c_) { G = G_; c = c_; nch4 = c_ < 256 ? 4 * ((256 - c_ + G_ - 1) / G_) : 0; }
    __host__ __device__ bool next(int i, Unit& u) const {
        const bool lat = i < nch4; const int j = i - nch4, L = j * G + c, T = (i >> 2) * G + c;
        const int b = lat ? (i & 3) : (L >> 2), pnp = lat ? (T & 3) : (L & 3);
        u.pm = lat ? (T >> 2) : SEQ / BM; u.pn = b * 4 + pnp; u.kt0 = 0; u.nkt = 4;
        return lat || (L < 16);
    }
};
struct EpiGateAcc {
    static constexpr bool PERM = true;
    const bf16_t* Gp; int ldg; bf16_t* MG; float* part;
    __device__ __forceinline__ void operator()(const f32x4 (&acc)[2][2][4][2], const Unit& u, int wr, int wc, int fr, int fq) const {
        const int b = u.pn >> 2, pnp = u.pn & 3;
        const int rloc = wr * 64 + fr, colg = u.pn * BM + wc * 32 + 8 * fq, colm = pnp * BM + wc * 32 + 8 * fq;
        const bool ctx = u.pm == SEQ / BM;
#pragma unroll
        for (int ai = 0; ai < 2; ++ai)
#pragma unroll
            for (int m = 0; m < 4; ++m) {
                const int rl = rloc + ai * HALF + m * 16;
                const bf16_t* gp_ = Gp + (size_t)(u.pm * BM + rl) * ldg + colg;
#pragma unroll
                for (int bj = 0; bj < 2; ++bj) {
                    const u32x4 gp = *(const u32x4*)(gp_ + bj * HALF);
                    const f32x4 v0 = acc[ai][bj][m][0], v1 = acc[ai][bj][m][1];
                    f32x4 z0 = {sigmoidf_(lo16(gp.x)) * v0[0], sigmoidf_(hi16(gp.x)) * v0[1], sigmoidf_(lo16(gp.y)) * v0[2], sigmoidf_(hi16(gp.y)) * v0[3]};
                    f32x4 z1 = {sigmoidf_(lo16(gp.z)) * v1[0], sigmoidf_(hi16(gp.z)) * v1[1], sigmoidf_(lo16(gp.w)) * v1[2], sigmoidf_(hi16(gp.w)) * v1[3]};
                    if (ctx) {
                        float* pp = part + ((size_t)(b * 256 + rl)) * D + colm + bj * HALF;
                        *(f32x4*)pp = z0; *(f32x4*)(pp + 4) = z1;
                    } else {
                        bf16_t* mp = MG + (size_t)(u.pm * BM + rl) * D + colm + bj * HALF;
                        if (b != 0) { const u32x4 pv = *(const u32x4*)mp;
                            z0 += (f32x4){lo16(pv.x), hi16(pv.x), lo16(pv.y), hi16(pv.y)}; z1 += (f32x4){lo16(pv.z), hi16(pv.z), lo16(pv.w), hi16(pv.w)}; }
                        u32x4 w; w.x = pk2(z0[0], z0[1]); w.y = pk2(z0[2], z0[3]); w.z = pk2(z1[0], z1[1]); w.w = pk2(z1[2], z1[3]);
                        *(u32x4*)mp = w;
                    }
                    asm volatile("" ::: "memory");
                }
            }
    }
};

template <class Epi, class Sched>
__device__ __forceinline__ void gemm_phase(LAS unsigned char* lds, const Gemm g, const Sched& S, const Epi& E, const int tid) {
    const int wid = __builtin_amdgcn_readfirstlane(tid >> 6), lane = tid & 63, wr = wid >> 2, wc = wid & 3, fr = lane & 15, fq = lane >> 4;
    const int K = g.K, lda = g.lda;
    unsigned voffA[2], voffB[2];
#pragma unroll
    for (int i = 0; i < 2; ++i) { int R, C; stage_rc(tid * 16 + i * 8192, R, C); const int Rb = Epi::PERM ? ((R & ~31) + perm32(R & 31)) : R;
        voffA[i] = (unsigned)(R * lda + C) * 2u; voffB[i] = (unsigned)(Rb * K + C) * 2u; }
    const size_t kstep = (size_t)(BK * 2);
    const size_t hstepA = (size_t)HALF * lda * 2, hstepB = (size_t)HALF * K * 2;
    const size_t tstepA = 2 * hstepA, tstepB = 2 * hstepB;
    const unsigned ldsw = (unsigned)wid * 1024u;
    const int aoff = lds_byte(wr * 64 + fr, fq * 8), boff = lds_byte(wc * 32 + fr, fq * 8);
#define PG8_UA(u) ((const char*)g.A + (size_t)(u).pm * tstepA + (size_t)(((u).pn >> g.a_sh) * g.a_str) + (size_t)(u).kt0 * kstep)
#define PG8_UB(u) ((const char*)g.Bt + (size_t)(u).pn * tstepB + (size_t)(u).kt0 * kstep)
#define PG8_SA(b, h) (((b) * 2 + (h)) * HTB)
#define PG8_SB(b, h) ((4 + (b) * 2 + (h)) * HTB)
#define PG8_STAGE(bufoff, gbase, voff) do { _Pragma("unroll") for (int _i = 0; _i < 2; ++_i) \
        __builtin_amdgcn_global_load_lds((const unsigned*)((const char*)(gbase) + (voff)[_i]), (LAS unsigned*)(lds + (bufoff) + ldsw + _i * 8192), 16, 0, 0); } while (0)
#define PG8_LDA(dst, b, h) do { _Pragma("unroll") for (int m = 0; m < 4; ++m) _Pragma("unroll") for (int k = 0; k < 2; ++k) dst[m][k] = *(const LAS bf16x8*)(lds + PG8_SA(b, h) + aoff + m * 2048 + k * 1024); } while (0)
#define PG8_LDB(dst, b, h) do { _Pragma("unroll") for (int n = 0; n < 2; ++n) _Pragma("unroll") for (int k = 0; k < 2; ++k) dst[n][k] = *(const LAS bf16x8*)(lds + PG8_SB(b, h) + boff + n * 2048 + k * 1024); } while (0)
#define PG8_MMA(ai, bj, At, Bt) do { __builtin_amdgcn_s_setprio(1); _Pragma("unroll") for (int m = 0; m < 4; ++m) _Pragma("unroll") for (int n = 0; n < 2; ++n) _Pragma("unroll") for (int k = 0; k < 2; ++k) \
        acc[ai][bj][m][n] = __builtin_amdgcn_mfma_f32_16x16x32_bf16(Bt[n][k], At[m][k], acc[ai][bj][m][n], 0, 0, 0); __builtin_amdgcn_s_setprio(0); } while (0)
#define PG8_WAIT_V(n) asm volatile("s_waitcnt vmcnt(" #n ")" ::: "memory")
#define PG8_WAIT_L(n) asm volatile("s_waitcnt lgkmcnt(" #n ")" ::: "memory")
#define PG8_BAR __builtin_amdgcn_s_barrier()
#define PG8_SCHED __builtin_amdgcn_sched_barrier(0)
    Unit cur, nxt; int ui = 0;
    if (!S.next(0, cur)) return;
    f32x4 acc[2][2][4][2];
#pragma unroll
    for (int a = 0; a < 2; ++a)
#pragma unroll
        for (int b = 0; b < 2; ++b)
#pragma unroll
            for (int m = 0; m < 4; ++m)
#pragma unroll
                for (int n = 0; n < 2; ++n) acc[a][b][m][n] = (f32x4){0.f, 0.f, 0.f, 0.f};
    bf16x8 At[4][2], B0[2][2], B1[2][2];
    const char* cA = PG8_UA(cur); const char* cB = PG8_UB(cur);
    PG8_STAGE(PG8_SB(0, 0), cB, voffB); PG8_STAGE(PG8_SB(0, 1), cB + hstepB, voffB); PG8_STAGE(PG8_SA(0, 0), cA, voffA); PG8_STAGE(PG8_SA(0, 1), cA + hstepA, voffA);
    if (wr == 1) PG8_BAR;
    PG8_WAIT_V(2); PG8_BAR;
    PG8_STAGE(PG8_SB(1, 0), cB + kstep, voffB); PG8_STAGE(PG8_SA(1, 0), cA + kstep, voffA); PG8_STAGE(PG8_SB(1, 1), cB + hstepB + kstep, voffB);
    PG8_WAIT_V(6); PG8_BAR;
    for (;;) {
        const bool has_next = S.next(ui + 1, nxt);
        const char* nA = has_next ? PG8_UA(nxt) : cA; const char* nB = has_next ? PG8_UB(nxt) : cB;
        const int nt = cur.nkt;
#pragma unroll 1
        for (int t = 0; t < nt; t += 2) {
            const bool last = (t == nt - 2);
            const char* a1 = cA + (size_t)(t + 1) * kstep;
            const char* a2 = last ? nA : cA + (size_t)(t + 2) * kstep; const char* b2 = last ? nB : cB + (size_t)(t + 2) * kstep;
            const char* a3 = a2 + kstep; const char* b3 = b2 + kstep;
            PG8_LDB(B0, 0, 0); PG8_LDB(B1, 0, 1); PG8_SCHED; PG8_LDA(At, 0, 0); PG8_STAGE(PG8_SA(1, 1), a1 + hstepA, voffA);
            PG8_WAIT_V(8); PG8_WAIT_L(0); PG8_BAR; PG8_MMA(0, 0, At, B0); PG8_MMA(0, 1, At, B1); PG8_BAR; PG8_SCHED;
            PG8_LDA(At, 0, 1); PG8_STAGE(PG8_SB(0, 0), b2, voffB); PG8_STAGE(PG8_SB(0, 1), b2 + hstepB, voffB); PG8_STAGE(PG8_SA(0, 0), a2, voffA);
            PG8_WAIT_V(8); PG8_WAIT_L(0); PG8_BAR; PG8_MMA(1, 0, At, B0); PG8_MMA(1, 1, At, B1); PG8_BAR; PG8_SCHED;
            PG8_LDB(B0, 1, 0); PG8_LDB(B1, 1, 1); PG8_SCHED; PG8_LDA(At, 1, 0); PG8_STAGE(PG8_SA(0, 1), a2 + hstepA, voffA);
            PG8_WAIT_V(8); PG8_WAIT_L(0); PG8_BAR; PG8_MMA(0, 0, At, B0); PG8_MMA(0, 1, At, B1); PG8_BAR; PG8_SCHED;
            PG8_LDA(At, 1, 1); PG8_STAGE(PG8_SB(1, 0), b3, voffB); PG8_STAGE(PG8_SB(1, 1), b3 + hstepB, voffB); PG8_STAGE(PG8_SA(1, 0), a3, voffA);
            PG8_WAIT_V(8); PG8_WAIT_L(0); PG8_BAR; PG8_MMA(1, 0, At, B0); PG8_MMA(1, 1, At, B1); PG8_BAR; PG8_SCHED;
        }
        if (wr == 0) PG8_BAR;
        E(acc, cur, wr, wc, fr, fq);
        if (!has_next) break;
#pragma unroll
        for (int a = 0; a < 2; ++a)
#pragma unroll
            for (int b = 0; b < 2; ++b)
#pragma unroll
                for (int m = 0; m < 4; ++m)
#pragma unroll
                    for (int n = 0; n < 2; ++n) acc[a][b][m][n] = (f32x4){0.f, 0.f, 0.f, 0.f};
        cur = nxt; cA = nA; cB = nB; ++ui;
        if (wr == 1) PG8_BAR;
    }
    PG8_WAIT_V(0);
    PG8_BAR;
#undef PG8_UA
#undef PG8_UB
#undef PG8_SA
#undef PG8_SB
#undef PG8_STAGE
#undef PG8_LDA
#undef PG8_LDB
#undef PG8_MMA
#undef PG8_WAIT_V
#undef PG8_WAIT_L
#undef PG8_BAR
#undef PG8_SCHED
}
}

struct Args {
    const float* in[26];
    float* out; unsigned char* ws;
    int ph_lo, ph_hi;
};
__device__ __forceinline__ const float* in_ptr(int i) {
    const __attribute__((address_space(4))) char* ka = (const __attribute__((address_space(4))) char*)__builtin_amdgcn_kernarg_segment_ptr();
    int off = i * 8; asm volatile("" : "+s"(off));
    return *(const float* const __attribute__((address_space(4)))*)(ka + off);
}
struct Ctx {
    LAS unsigned char* lds;
    int tid, lane, wave, G, bid, gw, ngw;
};

__device__ __forceinline__ void transpose_item(const float* __restrict__ W, int K, int N, bf16_t* __restrict__ WT, int ldw, int koff, int row_off, int mode, LAS float* scr, int item, int lane) {
    const int nblk = N / 32, kb = item / nblk, nb = item % nblk, k0 = 64 * kb, n0 = 32 * nb;
#pragma unroll
    for (int i = 0; i < 32; ++i) { const int kk = 2 * i + (lane >> 5); scr[kk * 33 + (lane & 31)] = W[(size_t)(k0 + kk) * N + n0 + (lane & 31)]; }
    asm volatile("s_waitcnt lgkmcnt(0)" ::: "memory");
    const int c = lane & 7;
#pragma unroll
    for (int j = 0; j < 4; ++j) { const int n = (lane >> 3) + 8 * j; const LAS float* s = scr + (8 * c) * 33 + n;
        u32x4 o; o.x = pk2(s[0 * 33], s[1 * 33]); o.y = pk2(s[2 * 33], s[3 * 33]); o.z = pk2(s[4 * 33], s[5 * 33]); o.w = pk2(s[6 * 33], s[7 * 33]);
        const int ng = n0 + n;
        const int dr = mode == 0 ? ng : (((ng >> 4) << 5) + (ng & 15) + (mode == 2 ? 16 : 0));
        *(u32x4*)(WT + (size_t)(row_off + dr) * ldw + koff + k0 + 8 * c) = o; }
    asm volatile("s_waitcnt lgkmcnt(0)" ::: "memory");
}

__device__ __forceinline__ void phase0(const Ctx& F, const Args& a) {
    unsigned char* ws = a.ws;
    {
        LAS float* sc = (LAS float*)F.lds;
        const float* cvec = in_ptr(1); const float* cctx = in_ptr(3); const float* w_ada = in_ptr(4); const float* b_ada = in_ptr(5);
        float* MOD = (float*)(ws + WS_MOD);
        for (int k = F.tid; k < 2048; k += 512) { const float c = (k < 1024) ? cvec[k] : cctx[k - 1024]; sc[k] = siluf_(c); }
        __syncthreads();
        LAS float* red = sc + 2048;
        for (int it = F.bid; it < DEPTH * 144; it += F.G) {
            const int l = it / 144, n = (it % 144) * 64 + F.lane, k0 = F.wave * 128;
            const float* w = w_ada + (size_t)l * D * NMODV + (size_t)k0 * NMODV + n; float a0 = 0.f, a1 = 0.f;
#pragma unroll 16
            for (int k = 0; k < 128; ++k) { const float wv = w[(size_t)k * NMODV]; a0 += sc[k0 + k] * wv; a1 += sc[1024 + k0 + k] * wv; }
            red[(F.wave * 2 + 0) * 64 + F.lane] = a0; red[(F.wave * 2 + 1) * 64 + F.lane] = a1;
            __syncthreads();
            if (F.wave < 2) { float s = b_ada[l * NMODV + n];
#pragma unroll
                for (int ww = 0; ww < 8; ++ww) s += red[(ww * 2 + F.wave) * 64 + F.lane];
                MOD[(size_t)(l * 2 + F.wave) * NMODV + n] = s; }
            __syncthreads();
        }
    }
    {
        LAS float* scr = (LAS float*)(F.lds + F.wave * 16384);
        constexpr int I_FF = 16 * 88, I_DN = 44 * 32, I_IN = 16 * 216, I_B = 4 * 32, I_O = 16 * 32;
        constexpr int PER_LAYER = 4 * I_FF + 2 * I_DN + I_IN + 4 * I_B + I_O;
        for (int it = F.gw; it < PER_LAYER * DEPTH; it += F.ngw) {
            const int l = it / PER_LAYER; int r = it % PER_LAYER;
            bf16_t* WL = (bf16_t*)(ws + WS_W) + (size_t)l * LAYER_W;
            if (r < I_FF) { transpose_item(in_ptr(7) + (size_t)l * D * DFF, D, DFF, WL + O_WGU1, D, 0, 0, 1, scr, r, F.lane); continue; } r -= I_FF;
            if (r < I_FF) { transpose_item(in_ptr(8) + (size_t)l * D * DFF, D, DFF, WL + O_WGU1, D, 0, 0, 2, scr, r, F.lane); continue; } r -= I_FF;
            if (r < I_DN) { transpose_item(in_ptr(9) + (size_t)l * DFF * D, DFF, D, WL + O_WD1, DFF, 0, 0, 0, scr, r, F.lane); continue; } r -= I_DN;
            if (r < I_IN) { transpose_item(in_ptr(11) + (size_t)l * D * INW, D, INW, WL + O_WIN, D, 0, 0, 0, scr, r, F.lane); continue; } r -= I_IN;
            if (r < 4 * I_B) { const int b = r / I_B; transpose_item(in_ptr(19) + ((size_t)l * 4 + b) * 256 * D, 256, D, WL + O_WB, 256, 0, b * 1024, 0, scr, r % I_B, F.lane); continue; } r -= 4 * I_B;
            if (r < I_O) { transpose_item(in_ptr(20) + (size_t)l * D * D, D, D, WL + O_WO4, D, 0, 0, 0, scr, r, F.lane); continue; } r -= I_O;
            if (r < I_FF) { transpose_item(in_ptr(22) + (size_t)l * D * DFF, D, DFF, WL + O_WGU2, D, 0, 0, 1, scr, r, F.lane); continue; } r -= I_FF;
            if (r < I_FF) { transpose_item(in_ptr(23) + (size_t)l * D * DFF, D, DFF, WL + O_WGU2, D, 0, 0, 2, scr, r, F.lane); continue; } r -= I_FF;
            transpose_item(in_ptr(24) + (size_t)l * DFF * D, DFF, D, WL + O_WD2, DFF, 0, 0, 0, scr, r, F.lane);
        }
    }
    {
        f32x4* X4 = (f32x4*)(ws + WS_X); const f32x4* x4 = (const f32x4*)in_ptr(0); const f32x4* c4 = (const f32x4*)in_ptr(2);
        const size_t n1 = (size_t)SEQ * D / 4, n2 = (size_t)CTX * D / 4;
        for (size_t i = (size_t)F.bid * 512 + F.tid; i < n1 + n2; i += (size_t)F.G * 512) X4[i] = i < n1 ? x4[i] : c4[i - n1];
    }
}

__device__ __forceinline__ void norm_phase(const Ctx& F, float* X, const float* gw, const float* modl, int ish, int isc, bf16_t* XN, const float* part, int nsplit) {
    for (int row = SEQ + F.gw; row < NTOK; row += F.ngw) {
        const float* mv = modl + NMODV;
        f32x4* xr = (f32x4*)(X + (size_t)row * D) + F.lane;
        f32x4 v[4];
#pragma unroll
        for (int j = 0; j < 4; ++j) v[j] = xr[64 * j];
        const f32x4* pr = (const f32x4*)(part + (size_t)(row - SEQ) * D) + F.lane;
        int s = 0;
        for (; s + 4 <= nsplit; s += 4) {
            f32x4 t[4][4];
#pragma unroll
            for (int u = 0; u < 4; ++u)
#pragma unroll
                for (int j = 0; j < 4; ++j) t[u][j] = pr[(size_t)(s + u) * (256 * D / 4) + 64 * j];
#pragma unroll
            for (int u = 0; u < 4; ++u)
#pragma unroll
                for (int j = 0; j < 4; ++j) v[j] += t[u][j];
        }
        for (; s < nsplit; ++s)
#pragma unroll
            for (int j = 0; j < 4; ++j) v[j] += pr[(size_t)s * (256 * D / 4) + 64 * j];
        if (nsplit > 0) {
#pragma unroll
            for (int j = 0; j < 4; ++j) xr[64 * j] = v[j];
        }
        float ss = 0.f;
#pragma unroll
        for (int j = 0; j < 4; ++j) ss += (v[j].x * v[j].x + v[j].y * v[j].y) + (v[j].z * v[j].z + v[j].w * v[j].w);
        const float rs = __builtin_amdgcn_rsqf(wave_sum(ss) * (1.f / D) + EPSN);
#pragma unroll
        for (int j = 0; j < 4; ++j) {
            const int col = 4 * F.lane + 256 * j;
            const f32x4 g4 = *(const f32x4*)(gw + col), sh = *(const f32x4*)(mv + ish * 1024 + col), sc = *(const f32x4*)(mv + isc * 1024 + col);
            const f32x4 o = (v[j] * rs) * (g4 * (sc + 1.0f)) + sh;
            u32x2 w; w.x = pk2(o.x, o.y); w.y = pk2(o.z, o.w);
            *(u32x2*)(XN + (size_t)row * D + col) = w;
        }
    }
    for (int row0 = 4 * F.gw; row0 < SEQ; row0 += 4 * F.ngw) {
        const float* mv = modl;
        f32x4 v[4][4];
#pragma unroll
        for (int r = 0; r < 4; ++r) { const f32x4* xr = (const f32x4*)(X + (size_t)(row0 + r) * D) + F.lane;
#pragma unroll
            for (int j = 0; j < 4; ++j) v[r][j] = xr[64 * j]; }
        float rs[4];
#pragma unroll
        for (int r = 0; r < 4; ++r) { float ss = 0.f;
#pragma unroll
            for (int j = 0; j < 4; ++j) ss += (v[r][j].x * v[r][j].x + v[r][j].y * v[r][j].y) + (v[r][j].z * v[r][j].z + v[r][j].w * v[r][j].w);
            rs[r] = __builtin_amdgcn_rsqf(wave_sum(ss) * (1.f / D) + EPSN); }
#pragma unroll
        for (int j = 0; j < 4; ++j) {
            const int col = 4 * F.lane + 256 * j;
            const f32x4 g4 = *(const f32x4*)(gw + col), sh = *(const f32x4*)(mv + ish * 1024 + col), sc = *(const f32x4*)(mv + isc * 1024 + col);
            const f32x4 gs = g4 * (sc + 1.0f);
#pragma unroll
            for (int r = 0; r < 4; ++r) {
                const f32x4 o = (v[r][j] * rs[r]) * gs + sh;
                u32x2 w; w.x = pk2(o.x, o.y); w.y = pk2(o.z, o.w);
                *(u32x2*)(XN + (size_t)(row0 + r) * D + col) = w;
            }
        }
    }
}
__device__ __forceinline__ void final_norm_phase(const Ctx& F, const float* X, const float* gw, float* out) {
    for (int row = F.gw; row < SEQ; row += F.ngw) {
        const f32x4* xr = (const f32x4*)(X + (size_t)row * D) + F.lane;
        f32x4 v[4]; float ss = 0.f;
#pragma unroll
        for (int j = 0; j < 4; ++j) { v[j] = xr[64 * j]; ss += (v[j].x * v[j].x + v[j].y * v[j].y) + (v[j].z * v[j].z + v[j].w * v[j].w); }
        const float rs = 1.0f / sqrtf(wave_sum(ss) * (1.f / D) + EPSN);
#pragma unroll
        for (int j = 0; j < 4; ++j) { const int col = 4 * F.lane + 256 * j; *(f32x4*)(out + (size_t)row * D + col) = v[j] * rs * *(const f32x4*)(gw + col); }
    }
}

__device__ __forceinline__ void prep_qk(bf16_t* PB, int tok0, int col, const float* gain, bool rope, float outscale, int lane) {
    const int i = lane & 15, tq = lane >> 4;
    const float g0 = gain[i], g1 = gain[16 + i], g2 = gain[32 + i], g3 = gain[48 + i];
    const float inv = exp2f(-(float)i * 0.83048202372184059f);
#pragma unroll 4
    for (int pass = 0; pass < 16; ++pass) {
        const int tok = tok0 + pass * 4 + tq;
        bf16_t* p = PB + (size_t)tok * INW + col + i;
        float x0 = bf2f(p[0]), x1 = bf2f(p[16]), x2 = bf2f(p[32]), x3 = bf2f(p[48]);
        float ss = (x0 * x0 + x1 * x1) + (x2 * x2 + x3 * x3);
        ss += swz_xor<1>(ss); ss += swz_xor<2>(ss); ss += swz_xor<4>(ss); ss += swz_xor<8>(ss);
        const float r = 1.0f / sqrtf(ss * (1.f / 64.f) + EPSN);
        x0 = x0 * r * g0; x1 = x1 * r * g1; x2 = x2 * r * g2; x3 = x3 * r * g3;
        if (rope) {
            const float ar = (float)(tok >> 6) * inv, ac = (float)(tok & 63) * inv;
            const float sr = __sinf(ar), cr = __cosf(ar), sc = __sinf(ac), cc = __cosf(ac);
            const float a0 = x0, b0 = x1; x0 = a0 * cr - b0 * sr; x1 = b0 * cr + a0 * sr;
            const float a1 = x2, b1 = x3; x2 = a1 * cc - b1 * sc; x3 = b1 * cc + a1 * sc;
        }
        p[0] = (bf16_t)f2bf(x0 * outscale); p[16] = (bf16_t)f2bf(x1 * outscale); p[32] = (bf16_t)f2bf(x2 * outscale); p[48] = (bf16_t)f2bf(x3 * outscale);
    }
}
__device__ __forceinline__ void prep_vt(const bf16_t* PB, int tok0, int col, bf16_t* VT, LAS unsigned char* scr, int lane) {
    const bf16_t* p = PB + (size_t)(tok0 + lane) * INW + col;
    LAS unsigned* s32 = (LAS unsigned*)scr;
#pragma unroll
    for (int c = 0; c < 8; ++c) { const u32x4 w = *(const u32x4*)(p + 8 * c);
        s32[lane * 33 + 4 * c + 0] = w.x; s32[lane * 33 + 4 * c + 1] = w.y; s32[lane * 33 + 4 * c + 2] = w.z; s32[lane * 33 + 4 * c + 3] = w.w; }
    asm volatile("s_waitcnt lgkmcnt(0)" ::: "memory");
    const LAS bf16_t* s16 = (const LAS bf16_t*)scr;
    bf16_t* o = VT + (size_t)lane * NTOK + tok0;
#pragma unroll
    for (int c = 0; c < 8; ++c) { u32x4 w; unsigned t[8];
#pragma unroll
        for (int e = 0; e < 8; ++e) t[e] = s16[(8 * c + e) * 66 + lane];
        w.x = t[0] | (t[1] << 16); w.y = t[2] | (t[3] << 16); w.z = t[4] | (t[5] << 16); w.w = t[6] | (t[7] << 16);
        *(u32x4*)(o + 8 * c) = w; }
    asm volatile("s_waitcnt lgkmcnt(0)" ::: "memory");
}
__device__ __forceinline__ float lb_val(const float* logits, int l, int dir, int ch) {
    float v[4]; float mx = -3.0e38f;
#pragma unroll
    for (int j = 0; j < 4; ++j) { v[j] = logits[(j * 2 + dir) * 256 + ch]; mx = fmaxf(mx, v[j]); }
    float s = 0.f, c = 0.f;
#pragma unroll
    for (int j = 0; j < 4; ++j) { v[j] = expf(v[j] - mx); s += v[j]; if (j >= 1 && j <= l) c += v[j]; }
    return c / s;
}
__device__ __forceinline__ int hg_row(int dir, int c, int s) {
    const int p = 64 * c + s;
    if (dir == 0) return p < CTX ? SEQ + p : p - CTX;
    return p < CTX ? SEQ + (CTX - 1) - p : (SEQ - 1) - (p - CTX);
}
__device__ __forceinline__ void hgrn_h1_item(const Ctx& F, const bf16_t* PB, const float* logits, int l, int item, float* GS, float* HA, LAS unsigned char* scrb) {
    const int head = item & 3, c = (item >> 2) % NCHUNK, dir = item / (4 * NCHUNK), lane = F.lane, q_ = lane & 31, h = lane >> 5;
    constexpr int TP = 144;
    LAS unsigned char* TKh = scrb;
    const int colf = (dir ? C_BFB : C_BFF) + head * 64 + lane;
    const float lb = lb_val(logits, l, dir, head * 64 + lane);
    float r = 0.f;
#pragma unroll
    for (int cb = 7; cb >= 0; --cb) {
        float kh[8];
#pragma unroll
        for (int i = 7; i >= 0; --i) {
            const float pre = bf2f(PB[(size_t)hg_row(dir, c, 8 * cb + i) * INW + colf]);
            const float f = lb + (1.0f - lb) * sigmoidf_(pre);
            kh[i] = (1.0f - f) * __expf(r);
            r += __logf(f);
        }
        const u32x4 w = {pk2(kh[0], kh[1]), pk2(kh[2], kh[3]), pk2(kh[4], kh[5]), pk2(kh[6], kh[7])};
        *(LAS u32x4*)(TKh + lane * TP + 16 * cb) = w;
    }
    HA[(size_t)((dir * NCHUNK + c) * 4 + head) * 64 + lane] = __expf(r);
    asm volatile("s_waitcnt lgkmcnt(0)" ::: "memory");
    __builtin_amdgcn_wave_barrier();
    f32x16 g[2][2];
#pragma unroll
    for (int r2 = 0; r2 < 16; ++r2) { g[0][0][r2] = 0.f; g[0][1][r2] = 0.f; g[1][0][r2] = 0.f; g[1][1][r2] = 0.f; }
    const bf16_t* vbase = PB + C_BI + head * 64 + q_;
#pragma unroll
    for (int k = 0; k < 4; ++k) {
        const bf16x8 ka0 = *(const LAS bf16x8*)(TKh + q_ * TP + (16 * k + 8 * h) * 2), ka1 = *(const LAS bf16x8*)(TKh + (32 + q_) * TP + (16 * k + 8 * h) * 2);
#pragma unroll
        for (int vb = 0; vb < 2; ++vb) {
            unsigned e[8];
#pragma unroll
            for (int j = 0; j < 8; ++j) e[j] = vbase[(size_t)hg_row(dir, c, 16 * k + 8 * h + j) * INW + 32 * vb];
            const u32x4 w = {e[0] | (e[1] << 16), e[2] | (e[3] << 16), e[4] | (e[5] << 16), e[6] | (e[7] << 16)};
            const bf16x8 vf = __builtin_bit_cast(bf16x8, w);
            g[0][vb] = __builtin_amdgcn_mfma_f32_32x32x16_bf16(ka0, vf, g[0][vb], 0, 0, 0);
            g[1][vb] = __builtin_amdgcn_mfma_f32_32x32x16_bf16(ka1, vf, g[1][vb], 0, 0, 0);
        }
    }
    float* go = GS + ((size_t)((dir * NCHUNK + c) * 4 + head)) * 4096;
#pragma unroll
    for (int db = 0; db < 2; ++db)
#pragma unroll
        for (int vb = 0; vb < 2; ++vb)
#pragma unroll
            for (int r2 = 0; r2 < 16; ++r2) go[(32 * db + 8 * (r2 >> 2) + 4 * h + (r2 & 3)) * 64 + 32 * vb + q_] = g[db][vb][r2];
    asm volatile("s_waitcnt lgkmcnt(0)" ::: "memory");
    __builtin_amdgcn_wave_barrier();
}
__device__ __forceinline__ void pool_item(const Ctx& F, const bf16_t* PB, const float* wg  , const float* cscale  , bf16_t* Y, int item, LAS unsigned char* scrb) {
    const int g = item & 3, tile = item >> 2, lane = F.lane, q_ = lane & 31, h = lane >> 5;
    const int row0 = tile * 64, sb = row0 >= SEQ ? SEQ : 0, T = row0 >= SEQ ? CTX : SEQ, t0 = row0 - sb;
    const int half = 1 << g;
    LAS bf16_t* xs = (LAS bf16_t*)scrb;
    LAS unsigned char* PT = scrb + 10240;
    const bf16_t* xp = PB + (size_t)sb * INW + C_CX + 64 * g + lane;
#pragma clang loop vectorize(disable) interleave(disable) unroll_count(8)
    for (int i = 0; i < 80; ++i) { const int uc = min(max(t0 - 8 + i, 0), T - 1); xs[i * 64 + lane] = xp[(size_t)uc * INW]; }
    asm volatile("s_waitcnt lgkmcnt(0)" ::: "memory");
    float s = 0.f; int cnt = 0;
#pragma unroll
    for (int k = 0; k < 16; ++k) { const int dk = k - 8, u = t0 + dk; const bool ok = (dk >= -half) && (dk < half) && (u >= 0) && (u < T);
        const float xv = bf2f(xs[(8 + dk) * 64 + lane]); s += ok ? xv : 0.f; cnt += ok ? 1 : 0; }
#pragma unroll 4
    for (int tt = 0; tt < 64; ++tt) {
        if (tt > 0) { const int t = t0 + tt;
            if (t - 1 + half < T) { s += bf2f(xs[(tt + 7 + half) * 64 + lane]); ++cnt; }
            if (t - 1 - half >= 0) { s -= bf2f(xs[(tt + 7 - half) * 64 + lane]); --cnt; } }
        const float pooled = s * __builtin_amdgcn_rcpf((float)cnt) - bf2f(xs[(tt + 8) * 64 + lane]);
        *(LAS bf16_t*)(PT + tt * 128 + 2 * lane) = (bf16_t)f2bf(pooled);
    }
    asm volatile("s_waitcnt lgkmcnt(0)" ::: "memory");
    __builtin_amdgcn_wave_barrier();
    f32x16 acc[2][2];
#pragma unroll
    for (int r = 0; r < 16; ++r) { acc[0][0][r] = 0.f; acc[0][1][r] = 0.f; acc[1][0][r] = 0.f; acc[1][1][r] = 0.f; }
    const float* wp = wg + (size_t)g * 4096 + q_;
#pragma unroll
    for (int k = 0; k < 4; ++k) {
        const bf16x8 a0 = *(const LAS bf16x8*)(PT + q_ * 128 + (16 * k + 8 * h) * 2), a1 = *(const LAS bf16x8*)(PT + (32 + q_) * 128 + (16 * k + 8 * h) * 2);
#pragma unroll
        for (int vb = 0; vb < 2; ++vb) {
            float wv[8];
#pragma unroll
            for (int j = 0; j < 8; ++j) wv[j] = wp[(16 * k + 8 * h + j) * 64 + 32 * vb];
            const u32x4 w = {pk2(wv[0], wv[1]), pk2(wv[2], wv[3]), pk2(wv[4], wv[5]), pk2(wv[6], wv[7])};
            const bf16x8 wf = __builtin_bit_cast(bf16x8, w);
            acc[0][vb] = __builtin_amdgcn_mfma_f32_32x32x16_bf16(a0, wf, acc[0][vb], 0, 0, 0);
            acc[1][vb] = __builtin_amdgcn_mfma_f32_32x32x16_bf16(a1, wf, acc[1][vb], 0, 0, 0);
        }
    }
#pragma unroll
    for (int vb = 0; vb < 2; ++vb) {
        const float sc = cscale[64 * g + 32 * vb + q_];
#pragma unroll
        for (int tb = 0; tb < 2; ++tb)
#pragma unroll
            for (int r = 0; r < 16; ++r)
                Y[(size_t)(row0 + 32 * tb + 8 * (r >> 2) + 4 * h + (r & 3)) * D + 512 + 64 * g + 32 * vb + q_] = (bf16_t)f2bf(acc[tb][vb][r] * sc);
    }
    asm volatile("s_waitcnt lgkmcnt(0)" ::: "memory");
    __builtin_amdgcn_wave_barrier();
}

__device__ __forceinline__ void prep_h1_phase(LAS unsigned char* lds, unsigned char* ws, const float* logits, int l, int tid, int bid, int G) {
    Ctx F; F.lds = lds; F.tid = tid; F.lane = tid & 63; F.wave = __builtin_amdgcn_readfirstlane(tid >> 6); F.G = G; F.bid = bid; F.gw = bid * 8 + F.wave; F.ngw = G * 8;
    const bf16_t* PB = (const bf16_t*)(ws + WS_PB); float* GS = (float*)(ws + WS_XN); float* HA = (float*)(ws + WS_HA);
    LAS unsigned char* scr = F.lds + F.wave * 18432;
    for (int it = F.wave * F.G + F.bid; it < 2 * NCHUNK * 4; it += F.ngw) hgrn_h1_item(F, PB, logits, l, it, GS, HA, scr);
}
__device__ __forceinline__ void prep_pool_phase(const Ctx& F, const Args& a, int l) {
    unsigned char* ws = a.ws;
    const bf16_t* PB = (const bf16_t*)(ws + WS_PB); bf16_t* Y = (bf16_t*)(ws + WS_Y);
    LAS unsigned char* scr = F.lds + F.wave * 18432;
    for (int it = (7 - F.wave) * F.G + F.bid; it < NCHUNK * 4; it += F.ngw) pool_item(F, PB, in_ptr(16) + (size_t)l * 4 * 4096, in_ptr(17) + l * 256, Y, it, scr);
}
__device__ __forceinline__ void prep_qkv_phase(const Ctx& F, const Args& a, int l, int rep) {
    unsigned char* ws = a.ws;
    bf16_t* PB = (bf16_t*)(ws + WS_PB);
    bf16_t* VTA = (bf16_t*)(ws + WS_VTA); bf16_t* VTD = (bf16_t*)(ws + WS_VTD);
    LAS unsigned char* scr = F.lds + F.wave * 18432;
    const int nq = 4 * F.G, sl = (F.wave & 3) * F.G + F.bid;
    const int it_first = F.wave < 4 ? sl : 2 * nq + sl, it_step = F.wave < 4 ? nq : nq, it_end = F.wave < 4 ? 2 * nq : NCHUNK * 12;
    for (int it = it_first; it < it_end && it < NCHUNK * 12; it += it_step) {
        const int tile = it / 12, slot = it % 12, tok0 = tile * 64;
        int ln = F.lane; asm volatile("" : "+v"(ln));
        if (slot < 6 && rep > 0) continue;
        if (slot < 4) prep_qk(PB, tok0, C_AQ + 64 * slot, in_ptr(12) + l * 64, tok0 < SEQ, ATT_SCALE * LOG2E, ln);
        else if (slot < 6) prep_qk(PB, tok0, C_AK + 64 * (slot - 4), in_ptr(13) + l * 64, tok0 < SEQ, 1.0f, ln);
        else if (slot < 8) prep_vt(PB, tok0, C_AV + 64 * (slot - 6), VTA + (size_t)(slot - 6) * 64 * NTOK, scr, ln);
        else prep_vt(PB, tok0, C_DV + 64 * (slot - 8), VTD + (size_t)(slot - 8) * 64 * NTOK, scr, ln);
    }
}

template <bool NA>
__device__ __forceinline__ void attn_unit(LAS unsigned char* lds, const bf16_t* __restrict__ PB, const bf16_t* __restrict__ VT, bf16_t* __restrict__ Y,
                                          int q_tok0, int qcol, int kcol, int ycol, int ntiles, int loc_base, float qs,
                                          int na_r, int na_rs_base, int na_qc0, const float* relb, const int tid) {
    const int lane = tid & 63, q = lane & 31, h = lane >> 5;
    constexpr int KB = 9216, VB = 9216, VOFF = 2 * KB, BOFF = VOFF + 2 * VB;
    LAS float* biasL = (LAS float*)(lds + BOFF);
    bf16x8 qb[4];
    { const bf16_t* qp = PB + (size_t)(q_tok0 + q) * INW + qcol + 8 * h;
#pragma unroll
      for (int s = 0; s < 4; ++s) qb[s] = *(const bf16x8*)(qp + 16 * s); }
    __syncthreads();
    if (NA) { for (int i = tid; i < 465; i += 512) biasL[i] = relb[i] * LOG2E; }
    f32x16 o0, o1, negm;
#pragma unroll
    for (int r = 0; r < 16; ++r) { o0[r] = 0.f; o1[r] = 0.f; negm[r] = 0.f; }
    float m = 0.f, l = 0.f;
    const int srow = tid >> 3, sch = tid & 7;
    u32x4 kreg, vreg;
    { const int t0 = SEQ;
      kreg = *(const u32x4*)(PB + (size_t)(t0 + srow) * INW + kcol + 8 * sch); vreg = *(const u32x4*)(VT + (size_t)srow * NTOK + t0 + 8 * sch); }
    *(LAS u32x4*)(lds + srow * 144 + sch * 16) = kreg;
    { LAS unsigned char* vp = lds + VOFF + srow * 144 + (sch >> 1) * 32 + (sch & 1) * 8;
      *(LAS u32x2*)vp = (u32x2){vreg.x, vreg.y}; *(LAS u32x2*)(vp + 16) = (u32x2){vreg.z, vreg.w}; }
    __syncthreads();
    const int na_cs = NA ? min(max(na_qc0 + q - 8, 0), 48) : 0;
    const int na_rs = NA ? min(max(na_r - 4, 0), 248) : 0;
    for (int j = 0; j < ntiles; ++j) {
        const int cur = j & 1;
        if (j + 1 < ntiles) { const int t0 = (j + 1) < 4 ? SEQ + 64 * (j + 1) : loc_base + 64 * (j + 1 - 4);
            kreg = *(const u32x4*)(PB + (size_t)(t0 + srow) * INW + kcol + 8 * sch); vreg = *(const u32x4*)(VT + (size_t)srow * NTOK + t0 + 8 * sch); }
        bool active = true; int kr = 0;
        if (NA && j >= 4) { kr = na_rs_base + (j - 4); active = (kr >= na_rs) && (kr < na_rs + 8); }
        if (active) {
            const LAS unsigned char* kb = lds + cur * KB; const LAS unsigned char* vb = lds + VOFF + cur * VB;
            f32x16 p0, p1;
            if (NA) {
#pragma unroll
                for (int r = 0; r < 16; ++r) { p0[r] = 0.f; p1[r] = 0.f; }
            } else { p0 = negm; p1 = negm; }
            bf16x8 kf[8], vfr[8];
#pragma unroll
            for (int s = 0; s < 4; ++s) {
                kf[2 * s] = *(const LAS bf16x8*)(kb + q * 144 + (16 * s + 8 * h) * 2);
                kf[2 * s + 1] = *(const LAS bf16x8*)(kb + (q + 32) * 144 + (16 * s + 8 * h) * 2);
            }
#pragma unroll
            for (int s = 0; s < 4; ++s) {
                vfr[2 * s] = *(const LAS bf16x8*)(vb + q * 144 + 32 * s + 16 * h);
                vfr[2 * s + 1] = *(const LAS bf16x8*)(vb + (q + 32) * 144 + 32 * s + 16 * h);
            }
            __builtin_amdgcn_sched_barrier(0);
            __builtin_amdgcn_s_setprio(1);
#pragma unroll
            for (int s = 0; s < 4; ++s) {
                p0 = __builtin_amdgcn_mfma_f32_32x32x16_bf16(kf[2 * s], qb[s], p0, 0, 0, 0);
                p1 = __builtin_amdgcn_mfma_f32_32x32x16_bf16(kf[2 * s + 1], qb[s], p1, 0, 0, 0);
            }
            __builtin_amdgcn_s_setprio(0);
            if (NA) {
                if (j >= 4) {
                    const int dr = kr - na_r + 7, qc = na_qc0 + q;
#pragma unroll
                    for (int r = 0; r < 16; ++r) {
                        const int kc = 8 * (r >> 2) + 4 * h + (r & 3);
                        const bool v0 = (kc >= na_cs) && (kc < na_cs + 16), v1 = (kc + 32 >= na_cs) && (kc + 32 < na_cs + 16);
                        const int i0 = v0 ? dr * 31 + (kc - qc + 15) : 0, i1 = v1 ? dr * 31 + (kc + 32 - qc + 15) : 0;
                        const float b0 = biasL[i0], b1 = biasL[i1];
                        p0[r] = v0 ? p0[r] * qs + b0 - m : -INFINITY; p1[r] = v1 ? p1[r] * qs + b1 - m : -INFINITY;
                    }
                } else {
#pragma unroll
                    for (int r = 0; r < 16; ++r) { p0[r] = p0[r] * qs - m; p1[r] = p1[r] * qs - m; }
                }
            }
            float mx = fmaxf(fmaxf(p0[0], p1[0]), p0[1]), mx2 = fmaxf(fmaxf(p1[1], p0[2]), p1[2]);
#pragma unroll
            for (int r = 3; r < 15; r += 3) { mx = fmaxf(fmaxf(mx, p0[r]), p1[r]); mx2 = fmaxf(fmaxf(mx2, p0[r + 1]), p1[r + 1]); mx = fmaxf(fmaxf(mx, p0[r + 2]), p1[r + 2]); }
            mx = fmaxf(fmaxf(mx, mx2), fmaxf(p0[15], p1[15]));
            mx = xor32_max(mx);
            const bool need = (mx > 0.f) || (j == 0);
            if (__builtin_amdgcn_ballot_w64(need) != 0ull) {
                const float delta = need ? mx : 0.f;
                const float alpha = __builtin_amdgcn_exp2f(-delta);
                m += delta; l *= alpha;
#pragma unroll
                for (int r = 0; r < 16; ++r) { o0[r] *= alpha; o1[r] *= alpha; p0[r] -= delta; p1[r] -= delta; negm[r] = -m; }
            }
            float ls = 0.f;
#pragma unroll
            for (int r = 0; r < 16; ++r) { p0[r] = __builtin_amdgcn_exp2f(p0[r]); p1[r] = __builtin_amdgcn_exp2f(p1[r]); ls += p0[r] + p1[r]; }
            l += ls;
            bf16x8 pb[4];
            { u32x4 w;
              w.x = pk2(p0[0], p0[1]); w.y = pk2(p0[2], p0[3]); w.z = pk2(p0[4], p0[5]); w.w = pk2(p0[6], p0[7]); pb[0] = __builtin_bit_cast(bf16x8, w);
              w.x = pk2(p0[8], p0[9]); w.y = pk2(p0[10], p0[11]); w.z = pk2(p0[12], p0[13]); w.w = pk2(p0[14], p0[15]); pb[1] = __builtin_bit_cast(bf16x8, w);
              w.x = pk2(p1[0], p1[1]); w.y = pk2(p1[2], p1[3]); w.z = pk2(p1[4], p1[5]); w.w = pk2(p1[6], p1[7]); pb[2] = __builtin_bit_cast(bf16x8, w);
              w.x = pk2(p1[8], p1[9]); w.y = pk2(p1[10], p1[11]); w.z = pk2(p1[12], p1[13]); w.w = pk2(p1[14], p1[15]); pb[3] = __builtin_bit_cast(bf16x8, w); }
#pragma unroll
            for (int s = 0; s < 4; ++s) {
                const bf16x8 vf0 = vfr[2 * s], vf1 = vfr[2 * s + 1];
                o0 = __builtin_amdgcn_mfma_f32_32x32x16_bf16(vf0, pb[s], o0, 0, 0, 0);
                o1 = __builtin_amdgcn_mfma_f32_32x32x16_bf16(vf1, pb[s], o1, 0, 0, 0);
            }
        }
        if (j + 1 < ntiles) {
            *(LAS u32x4*)(lds + (cur ^ 1) * KB + srow * 144 + sch * 16) = kreg;
            LAS unsigned char* vp = lds + VOFF + (cur ^ 1) * VB + srow * 144 + (sch >> 1) * 32 + (sch & 1) * 8;
            *(LAS u32x2*)vp = (u32x2){vreg.x, vreg.y}; *(LAS u32x2*)(vp + 16) = (u32x2){vreg.z, vreg.w};
        }
        __syncthreads();
    }
    const float lt = xor32_sum(l), inv = 1.0f / lt;
    bf16_t* yp = Y + (size_t)(q_tok0 + q) * D + ycol + 4 * h;
#pragma unroll
    for (int g4 = 0; g4 < 4; ++g4) {
        u32x2 w0, w1;
        w0.x = pk2(o0[4 * g4] * inv, o0[4 * g4 + 1] * inv); w0.y = pk2(o0[4 * g4 + 2] * inv, o0[4 * g4 + 3] * inv);
        w1.x = pk2(o1[4 * g4] * inv, o1[4 * g4 + 1] * inv); w1.y = pk2(o1[4 * g4 + 2] * inv, o1[4 * g4 + 3] * inv);
        *(u32x2*)(yp + 8 * g4) = w0; *(u32x2*)(yp + 32 + 8 * g4) = w1;
    }
}

__device__ __forceinline__ void small_attn_phase(const Ctx& F, const Args& a, int l, int rep) {
    unsigned char* ws = a.ws;
    bf16_t* PB = (bf16_t*)(ws + WS_PB); bf16_t* Y = (bf16_t*)(ws + WS_Y);
    const bf16_t* VTA = (const bf16_t*)(ws + WS_VTA); const bf16_t* VTD = (const bf16_t*)(ws + WS_VTD);
    float* GS = (float*)(ws + WS_XN); const float* HA = (const float*)(ws + WS_HA);
    const int w = F.wave;
    const int nscan = F.G >= 128 ? 64 : 0;
    const int nwork = F.G - nscan;
    for (int it = (nscan ? F.bid - nwork : F.bid); rep == 0 && it >= 0 && it < 64; it += (nscan ? 64 : F.G)) {
        const int dh = it >> 3, dblk = it & 7, d = dblk * 8 + (F.tid >> 6), v = F.tid & 63;
        float S = 0.f;
        for (int c0 = 0; c0 < NCHUNK; c0 += 20) {
            float gq[20], aq[20];
#pragma unroll
            for (int j = 0; j < 20; ++j) { const size_t u = (size_t)((dh >> 2) * NCHUNK + c0 + j) * 4 + (dh & 3); gq[j] = GS[u * 4096 + d * 64 + v]; aq[j] = HA[u * 64 + d]; }
#pragma unroll
            for (int j = 0; j < 20; ++j) { const size_t u = (size_t)((dh >> 2) * NCHUNK + c0 + j) * 4 + (dh & 3); GS[u * 4096 + d * 64 + v] = S; S = aq[j] * S + gq[j]; }
        }
    }
    if (nscan && F.bid >= nwork) return;
    for (int u = F.bid; u < 256 + 8; u += nwork) {
        if (u < 256) {
            const int head = u & 3, rg = u >> 2, r = 4 * rg + (w >> 1);
            const int rs0 = min(max(4 * rg - 4, 0), 248), rs3 = min(max(4 * rg + 3 - 4, 0), 248);
            attn_unit<true>(F.lds, PB, VTD + (size_t)head * 64 * NTOK, Y, 64 * r + 32 * (w & 1), C_DQ + 64 * head, C_DK + 64 * head, 768 + 64 * head, 4 + (rs3 + 8 - rs0), 64 * rs0,
                            ATT_SCALE * LOG2E, r, rs0, 32 * (w & 1), in_ptr(18) + ((size_t)l * 4 + head) * 465, F.tid);
        } else if (u < 260) { const int uu = u - 256, kvh = uu & 1, t128 = uu >> 1, hq = 2 * kvh + (w >> 2);
            attn_unit<false>(F.lds, PB, VTA + (size_t)kvh * 64 * NTOK, Y, SEQ + t128 * 128 + 32 * (w & 3), C_AQ + 64 * hq, C_AK + 64 * kvh, 64 * hq, 4, 0, 1.0f, 0, 0, 0, nullptr, F.tid);
        } else { const int head = u - 260;
            attn_unit<true>(F.lds, PB, VTD + (size_t)head * 64 * NTOK, Y, SEQ + 32 * w, C_DQ + 64 * head, C_DK + 64 * head, 768 + 64 * head, 4, 0, ATT_SCALE * LOG2E, 0, 0, 0, in_ptr(18) + ((size_t)l * 4 + head) * 465, F.tid);
        }
    }
}
__device__ __forceinline__ void attn_phase(const Ctx& F, const Args& a, int l) {
    unsigned char* ws = a.ws;
    bf16_t* PB = (bf16_t*)(ws + WS_PB); bf16_t* Y = (bf16_t*)(ws + WS_Y);
    const bf16_t* VTA = (const bf16_t*)(ws + WS_VTA);
    const int w = F.wave;
    for (int u = F.bid; u < 256; u += F.G) {
        const int kvh = u & 1, t128 = u >> 1, hq = 2 * kvh + (w >> 2);
        attn_unit<false>(F.lds, PB, VTA + (size_t)kvh * 64 * NTOK, Y, t128 * 128 + 32 * (w & 3), C_AQ + 64 * hq, C_AK + 64 * kvh, 64 * hq, 4 + SEQ / 64, 0, 1.0f, 0, 0, 0, nullptr, F.tid);
    }
}

__device__ __forceinline__ void ctxsum_phase(const Ctx& F, const float* part, bf16_t* MG) {
    for (int i = F.bid * 512 + F.tid; i < CTX * 128; i += F.G * 512) {
        const int r = i >> 7, c8 = (i & 127) * 8;
        const float* p = part + (size_t)r * D + c8;
        f32x4 a0 = *(const f32x4*)p, a1 = *(const f32x4*)(p + 4);
#pragma unroll
        for (int b = 1; b < 4; ++b) { a0 += *(const f32x4*)(p + (size_t)b * 256 * D); a1 += *(const f32x4*)(p + (size_t)b * 256 * D + 4); }
        u32x4 w; w.x = pk2(a0[0], a0[1]); w.y = pk2(a0[2], a0[3]); w.z = pk2(a1[0], a1[1]); w.w = pk2(a1[2], a1[3]);
        *(u32x4*)(MG + (size_t)(SEQ + r) * D + c8) = w;
    }
}

__device__ __forceinline__ void sum4_phase(const Ctx& F, const bf16_t* PB, bf16_t* MG) {
    for (int i = F.bid * 512 + F.tid; i < NTOK * 128; i += F.G * 512) {
        const int row = i >> 7, c8 = (i & 127) * 8;
        const bf16_t* zp = PB + (size_t)row * INW + C_GATE + c8;
        const u32x4 a = *(const u32x4*)zp, b = *(const u32x4*)(zp + 1024), c = *(const u32x4*)(zp + 2048), d = *(const u32x4*)(zp + 3072);
        u32x4 o;
        o.x = pk2((lo16(a.x) + lo16(b.x)) + (lo16(c.x) + lo16(d.x)), (hi16(a.x) + hi16(b.x)) + (hi16(c.x) + hi16(d.x)));
        o.y = pk2((lo16(a.y) + lo16(b.y)) + (lo16(c.y) + lo16(d.y)), (hi16(a.y) + hi16(b.y)) + (hi16(c.y) + hi16(d.y)));
        o.z = pk2((lo16(a.z) + lo16(b.z)) + (lo16(c.z) + lo16(d.z)), (hi16(a.z) + hi16(b.z)) + (hi16(c.z) + hi16(d.z)));
        o.w = pk2((lo16(a.w) + lo16(b.w)) + (lo16(c.w) + lo16(d.w)), (hi16(a.w) + hi16(b.w)) + (hi16(c.w) + hi16(d.w)));
        *(u32x4*)(MG + (size_t)row * D + c8) = o;
    }
}

__device__ __forceinline__ void hgrn_out_phase(const Ctx& F, const Args& a, int l) {
    unsigned char* ws = a.ws;
    const bf16_t* PB = (const bf16_t*)(ws + WS_PB); bf16_t* Y = (bf16_t*)(ws + WS_Y);
    const float* GS = (const float*)(ws + WS_XN);
    constexpr int WREG = 18432, TP = 144;
    const int lane = F.lane, dir = F.wave >> 2, wi = F.wave & 3, q_ = lane & 31, h = lane >> 5;
    LAS unsigned char* TQ = F.lds + F.wave * WREG;
    LAS unsigned char* TK = TQ + 9216;
    LAS float* ob = (LAS float*)TQ;
    const LAS float* ob_f = (const LAS float*)(F.lds + wi * WREG);
    const LAS float* ob_b = (const LAS float*)(F.lds + (wi + 4) * WREG);
    const float og = in_ptr(15)[l * 64 + lane];
    for (int it0 = 4 * F.bid; it0 < NCHUNK * 4; it0 += 4 * F.G) {
        const int it = it0 + wi;
        const int head = it & 3, jc = it >> 2;
        const int rb = jc < 256 ? 64 * jc : SEQ + 64 * (jc - 256);
        {
            const int c = dir == 0 ? (jc < 256 ? 4 + jc : jc - 256) : (jc < 256 ? 4 + 255 - jc : 3 - (jc - 256));
            const float lb = lb_val(in_ptr(14), l, dir, head * 64 + lane);
            const int colf = (dir ? C_BFB : C_BFF) + head * 64 + lane, colq = C_BQ + head * 64 + lane;
            float fv[64]; float ref = 0.f;
#pragma unroll
            for (int t = 0; t < 64; ++t) {
                const float pre = bf2f(PB[(size_t)(rb + (dir ? 63 - t : t)) * INW + colf]);
                const float f = lb + (1.0f - lb) * sigmoidf_(pre);
                fv[t] = f;
                if (t < 32) ref += __logf(f);
            }
            unsigned qh[32]; float cum = 0.f, qh_prev = 0.f;
#pragma unroll
            for (int t = 0; t < 64; ++t) {
                const float qv = bf2f(PB[(size_t)(rb + (dir ? 63 - t : t)) * INW + colq]) * 0.125f;
                cum += __logf(fv[t]);
                const float qt = qv * __expf(fminf(cum - ref, 80.f));
                const float kt = (1.0f - fv[t]) * __expf(fminf(ref - cum, 80.f));
                const float qhv = qv * __expf(cum);
                *(LAS bf16_t*)(TQ + t * TP + 2 * lane) = (bf16_t)f2bf(qt);
                *(LAS bf16_t*)(TK + t * TP + 2 * lane) = (bf16_t)f2bf(kt);
                if (t & 1) qh[t >> 1] = pk2(qh_prev, qhv); else qh_prev = qhv;
            }
            asm volatile("s_waitcnt lgkmcnt(0)" ::: "memory");
            __builtin_amdgcn_wave_barrier();
            f32x16 a00, a01, a11;
#pragma unroll
            for (int r = 0; r < 16; ++r) { a00[r] = 0.f; a01[r] = 0.f; a11[r] = 0.f; }
#pragma unroll
            for (int k = 0; k < 4; ++k) {
                const bf16x8 ka0 = *(const LAS bf16x8*)(TK + q_ * TP + (16 * k + 8 * h) * 2), ka1 = *(const LAS bf16x8*)(TK + (32 + q_) * TP + (16 * k + 8 * h) * 2);
                const bf16x8 qb0 = *(const LAS bf16x8*)(TQ + q_ * TP + (16 * k + 8 * h) * 2), qb1 = *(const LAS bf16x8*)(TQ + (32 + q_) * TP + (16 * k + 8 * h) * 2);
                a00 = __builtin_amdgcn_mfma_f32_32x32x16_bf16(ka0, qb0, a00, 0, 0, 0);
                a01 = __builtin_amdgcn_mfma_f32_32x32x16_bf16(ka0, qb1, a01, 0, 0, 0);
                a11 = __builtin_amdgcn_mfma_f32_32x32x16_bf16(ka1, qb1, a11, 0, 0, 0);
            }
#pragma unroll
            for (int r = 0; r < 16; ++r) { const bool ok = (8 * (r >> 2) + 4 * h + (r & 3)) <= q_; a00[r] = ok ? a00[r] : 0.f; a11[r] = ok ? a11[r] : 0.f; }
            bf16x8 p00[2], p01[2], p11[2];
#pragma unroll
            for (int k = 0; k < 2; ++k) { u32x4 w;
                w.x = pk2(a00[8 * k], a00[8 * k + 1]); w.y = pk2(a00[8 * k + 2], a00[8 * k + 3]); w.z = pk2(a00[8 * k + 4], a00[8 * k + 5]); w.w = pk2(a00[8 * k + 6], a00[8 * k + 7]); p00[k] = __builtin_bit_cast(bf16x8, w);
                w.x = pk2(a01[8 * k], a01[8 * k + 1]); w.y = pk2(a01[8 * k + 2], a01[8 * k + 3]); w.z = pk2(a01[8 * k + 4], a01[8 * k + 5]); w.w = pk2(a01[8 * k + 6], a01[8 * k + 7]); p01[k] = __builtin_bit_cast(bf16x8, w);
                w.x = pk2(a11[8 * k], a11[8 * k + 1]); w.y = pk2(a11[8 * k + 2], a11[8 * k + 3]); w.z = pk2(a11[8 * k + 4], a11[8 * k + 5]); w.w = pk2(a11[8 * k + 6], a11[8 * k + 7]); p11[k] = __builtin_bit_cast(bf16x8, w); }
            asm volatile("s_waitcnt lgkmcnt(0)" ::: "memory");
            __builtin_amdgcn_wave_barrier();
#pragma unroll
            for (int t2 = 0; t2 < 32; ++t2) { *(LAS bf16_t*)(TQ + (2 * t2) * TP + 2 * lane) = (bf16_t)(qh[t2] & 0xffffu); *(LAS bf16_t*)(TQ + (2 * t2 + 1) * TP + 2 * lane) = (bf16_t)(qh[t2] >> 16); }
            f32x16 o[2][2];
#pragma unroll
            for (int r = 0; r < 16; ++r) { o[0][0][r] = 0.f; o[0][1][r] = 0.f; o[1][0][r] = 0.f; o[1][1][r] = 0.f; }
            const bf16_t* vbase = PB + C_BI + head * 64 + q_;
#pragma unroll
            for (int cv = 0; cv < 2; ++cv)
#pragma unroll
                for (int sa = 0; sa < 2; ++sa)
#pragma unroll
                    for (int k = 0; k < 2; ++k) {
                        unsigned e[8];
#pragma unroll
                        for (int j = 0; j < 8; ++j) { const int s = 32 * sa + 16 * k + 8 * (j >> 2) + 4 * h + (j & 3); e[j] = vbase[(size_t)(rb + (dir ? 63 - s : s)) * INW + 32 * cv]; }
                        const u32x4 w = {e[0] | (e[1] << 16), e[2] | (e[3] << 16), e[4] | (e[5] << 16), e[6] | (e[7] << 16)};
                        const bf16x8 vf = __builtin_bit_cast(bf16x8, w);
                        if (sa == 0) { o[cv][0] = __builtin_amdgcn_mfma_f32_32x32x16_bf16(vf, p00[k], o[cv][0], 0, 0, 0); o[cv][1] = __builtin_amdgcn_mfma_f32_32x32x16_bf16(vf, p01[k], o[cv][1], 0, 0, 0); }
                        else o[cv][1] = __builtin_amdgcn_mfma_f32_32x32x16_bf16(vf, p11[k], o[cv][1], 0, 0, 0);
                    }
            asm volatile("s_waitcnt lgkmcnt(0)" ::: "memory");
            __builtin_amdgcn_wave_barrier();
            const float* sbase = GS + ((size_t)((dir * NCHUNK + c) * 4 + head)) * 4096 + q_;
#pragma unroll
            for (int cv = 0; cv < 2; ++cv)
#pragma unroll
                for (int k = 0; k < 4; ++k) {
                    float sv[8];
#pragma unroll
                    for (int j = 0; j < 8; ++j) sv[j] = sbase[(16 * k + 8 * h + j) * 64 + 32 * cv];
                    const u32x4 w = {pk2(sv[0], sv[1]), pk2(sv[2], sv[3]), pk2(sv[4], sv[5]), pk2(sv[6], sv[7])};
                    const bf16x8 sf = __builtin_bit_cast(bf16x8, w);
                    const bf16x8 qb0 = *(const LAS bf16x8*)(TQ + q_ * TP + (16 * k + 8 * h) * 2), qb1 = *(const LAS bf16x8*)(TQ + (32 + q_) * TP + (16 * k + 8 * h) * 2);
                    o[cv][0] = __builtin_amdgcn_mfma_f32_32x32x16_bf16(sf, qb0, o[cv][0], 0, 0, 0);
                    o[cv][1] = __builtin_amdgcn_mfma_f32_32x32x16_bf16(sf, qb1, o[cv][1], 0, 0, 0);
                }
            asm volatile("s_waitcnt lgkmcnt(0)" ::: "memory");
            __builtin_amdgcn_wave_barrier();
#pragma unroll
            for (int cv = 0; cv < 2; ++cv)
#pragma unroll
                for (int tb = 0; tb < 2; ++tb) {
                    const int t = 32 * tb + q_, tt = dir ? 63 - t : t;
#pragma unroll
                    for (int g4 = 0; g4 < 4; ++g4)
                        *(LAS f32x4*)(ob + tt * 64 + 32 * cv + 8 * g4 + 4 * h) = (f32x4){o[cv][tb][4 * g4], o[cv][tb][4 * g4 + 1], o[cv][tb][4 * g4 + 2], o[cv][tb][4 * g4 + 3]};
                }
        }
        __syncthreads();
        {
#pragma unroll 4
            for (int k = 0; k < 32; ++k) {
                const int tt = 32 * dir + k;
                const float ot = ob_f[tt * 64 + lane] + ob_b[tt * 64 + lane];
                const float ss = wave_sum(ot * ot);
                const float gg = bf2f(PB[(size_t)(rb + tt) * INW + C_BG + head * 64 + lane]);
                const float y = ot * (1.0f / sqrtf(ss * (1.f / 64.f) + EPSN)) * og * siluf_(gg);
                Y[(size_t)(rb + tt) * D + 256 + head * 64 + lane] = (bf16_t)f2bf(y);
            }
        }
        __syncthreads();
    }
}

#define XB_TMO      128
#define XB_XCNT(j)  (256  + 64 * (j))
#define XB_XSUB(j)  (1280 + 64 * (j))
#define XB_XGEN(j)  (2304 + 64 * (j))
#define XB_TOP      3328
#define XB_TOPGEN   3392
#define XCD_BAR_WORDS 3456
#define XB_SPIN_CAP (1u << 18)

__device__ __forceinline__ unsigned xb_ld(unsigned* p)              { return __hip_atomic_load(p, __ATOMIC_RELAXED, __HIP_MEMORY_SCOPE_AGENT); }
__device__ __forceinline__ unsigned xb_add(unsigned* p, unsigned v) { return __hip_atomic_fetch_add(p, v, __ATOMIC_RELAXED, __HIP_MEMORY_SCOPE_AGENT); }
__device__ __forceinline__ unsigned xb_xcc_id() { return (unsigned)__builtin_amdgcn_s_getreg((3 << 11) | 20) & 0xFu; }
#define XB_SPIN(cond, bar) do { unsigned _sp = 0; while (cond) { __builtin_amdgcn_s_sleep(1); \
    if ((++_sp & 255u) == 0u) { if (xb_ld(&(bar)[XB_TMO])) break; if (_sp > XB_SPIN_CAP) { atomicAdd(&(bar)[XB_TMO], 1u); break; } } } } while (0)

struct XcdBarrier {
    unsigned* bar; unsigned x;
    volatile LAS unsigned* st;
};

__device__ __forceinline__ XcdBarrier xcd_barrier_post(unsigned* bar, volatile LAS unsigned* st) {
    XcdBarrier b; b.bar = bar; b.x = xb_xcc_id(); b.st = st;
    if (threadIdx.x == 0) (void)xb_add(&bar[XB_XCNT(b.x)], 1u);
    return b;
}
__device__ __forceinline__ void xcd_barrier_complete(unsigned* bar, unsigned x, unsigned& nloc, unsigned& nx) {
    const unsigned G = gridDim.x * gridDim.y * gridDim.z;
    unsigned sum, cnt, mine, sp = 0u;
    for (;;) {
        sum = 0u; cnt = 0u; mine = 0u;
#pragma unroll
        for (unsigned j = 0; j < 16; ++j) { const unsigned c = xb_ld(&bar[XB_XCNT(j)]); sum += c; cnt += (c > 0u) ? 1u : 0u; mine = (j == x) ? c : mine; }
        if (sum == G) break;
        __builtin_amdgcn_s_sleep(1);
        if ((++sp & 255u) == 0u) { if (xb_ld(&bar[XB_TMO])) break; if (sp > XB_SPIN_CAP) { atomicAdd(&bar[XB_TMO], 1u); break; } }
    }
    nloc = mine > 0u ? mine : 1u; nx = cnt > 0u ? cnt : 1u;
}

__device__ __forceinline__ void xcd_barrier(const XcdBarrier& b) {
    asm volatile("s_waitcnt vmcnt(0)" ::: "memory");
    __syncthreads();
    if (threadIdx.x == 0) {
        unsigned* bar = b.bar;
        __builtin_amdgcn_s_waitcnt(0);
        unsigned nloc = b.st[0], nx = b.st[1];
        if (nloc == 0u) { xcd_barrier_complete(bar, b.x, nloc, nx); b.st[0] = nloc; b.st[1] = nx; }
        const unsigned old = xb_add(&bar[XB_XSUB(b.x)], 1u);
        const unsigned gen = old / nloc;
        if (old + 1u == (gen + 1u) * nloc) {
            __builtin_amdgcn_fence(__ATOMIC_RELEASE, "agent");
            asm volatile("s_waitcnt vmcnt(0)" ::: "memory");
            const unsigned og = xb_add(&bar[XB_TOP], 1u);
            const unsigned tg = og / nx;
            if (og + 1u == (tg + 1u) * nx) xb_add(&bar[XB_TOPGEN], 1u);
            else XB_SPIN(xb_ld(&bar[XB_TOPGEN]) == tg, bar);
            __builtin_amdgcn_fence(__ATOMIC_ACQUIRE, "agent");
            xb_add(&bar[XB_XGEN(b.x)], 1u);
            asm volatile("s_waitcnt vmcnt(0)" ::: "memory");
        } else {
            XB_SPIN(xb_ld(&bar[XB_XGEN(b.x)]) == gen, bar);
            __builtin_amdgcn_fence(__ATOMIC_ACQUIRE, "agent");
            asm volatile("s_waitcnt vmcnt(0)" ::: "memory");
        }
    }
    __syncthreads();
}

__device__ __forceinline__ Ctx relaunder(Ctx F) {
    int t = F.tid; asm volatile("" : "+v"(t));
    F.tid = t; F.lane = t & 63; F.wave = __builtin_amdgcn_readfirstlane(t >> 6); F.gw = F.bid * 8 + F.wave;
    return F;
}
__global__ void __launch_bounds__(512, 2) mk_fwd(Args args) {
    extern __shared__ __attribute__((aligned(16))) unsigned char lds_raw[];
    cg::grid_group grid = cg::this_grid();
    unsigned char* ws = args.ws;
    float* X = (float*)(ws + WS_X); bf16_t* XN = (bf16_t*)(ws + WS_XN); bf16_t* PB = (bf16_t*)(ws + WS_PB); bf16_t* Y = (bf16_t*)(ws + WS_Y);
    const int wave0 = __builtin_amdgcn_readfirstlane(threadIdx.x >> 6);
    volatile LAS unsigned* bar_st = (volatile LAS unsigned*)((LAS unsigned char*)lds_raw + (LDS_BYTES - 256));
    if (threadIdx.x < 2) bar_st[threadIdx.x] = 0u;
    __syncthreads();
    const XcdBarrier xbar = xcd_barrier_post((unsigned*)args.ws, bar_st);
    for (int ph = args.ph_lo; ph < args.ph_hi; ++ph) {
        unsigned z_; asm volatile("v_mov_b32 %0, 0" : "=v"(z_));
        const int lane_ = (int)__builtin_amdgcn_mbcnt_hi(~0u, __builtin_amdgcn_mbcnt_lo(~0u, z_)); int bid_ = blockIdx.x;
        asm volatile("" : "+s"(bid_));
        const int tid_ = wave0 * 64 + lane_;
        Ctx F0;
        F0.lds = (LAS unsigned char*)lds_raw;
        F0.tid = tid_; F0.lane = F0.tid & 63; F0.wave = wave0;
        F0.G = gridDim.x; F0.bid = bid_; F0.gw = F0.bid * 8 + F0.wave; F0.ngw = F0.G * 8;
        int nrep = 1;
        if (PROBE_DBL) { const int sp_ = (ph - 1) % NSUB;
            if (ph == 0) nrep = (PROBE_DBL & 1) ? 2 : 1;
            else if (ph == NPHASE - 1) nrep = (PROBE_DBL & 64) ? 2 : 1;
            else if (sp_ == 0 || sp_ == 3 || sp_ == 11) nrep = (PROBE_DBL & 2) ? 2 : 1;
            else if (sp_ == 1 || sp_ == 12) nrep = (PROBE_DBL & 4) ? 2 : 1;
            else if (sp_ == 4) nrep = (PROBE_DBL & 8) ? 2 : 1;
            else if (sp_ == 2 || sp_ == 13) nrep = (PROBE_DBL & 1024) ? 2 : 1;
            else if (sp_ == 10) nrep = (PROBE_DBL & 2048) ? 2 : 1;
            else if (sp_ == 5) nrep = (PROBE_DBL & 256) ? 2 : 1;
            else if (sp_ == 6) nrep = (PROBE_DBL & 512) ? 2 : 1;
            else if (sp_ == 7) nrep = (PROBE_DBL & 16) ? 2 : 1;
            }
        for (int rep = 0; rep < nrep; ++rep) {
        if (ph == 0) { if (PHM & 1) { const Ctx F = relaunder(F0); phase0(F, args); } }
        else if (ph == NPHASE - 1) { if (PHM & 2) { const Ctx F = relaunder(F0); final_norm_phase(F, X, in_ptr(25), args.out); } }
        else {
            const int l = (ph - 1) / NSUB, sp = (ph - 1) % NSUB;
            const float* modl = (const float*)(ws + WS_MOD) + (size_t)l * 2 * NMODV;
            const bf16_t* WL = (const bf16_t*)(ws + WS_W) + (size_t)l * LAYER_W;
            if ((PHM & 4) && sp == 0) { const Ctx F = relaunder(F0); norm_phase(F, X, in_ptr(6) + l * D, modl, 0, 1, XN, (const float*)(ws + WS_PART), l > 0 ? 11 : 0); }
            else if ((PHM & 4) && sp == 3) { const Ctx F = relaunder(F0); norm_phase(F, X, in_ptr(10) + l * D, modl, 3, 4, XN, (const float*)(ws + WS_PART), 11); }
            else if ((PHM & 4) && sp == 11) { const Ctx F = relaunder(F0); norm_phase(F, X, in_ptr(21) + l * D, modl, 6, 7, XN, (const float*)(ws + WS_PART), 8); }
            else if ((PHM & 8) && (sp == 1 || sp == 12)) {
                const Ctx F = relaunder(F0);
                pg8::Gemm g{XN, WL + (sp == 1 ? O_WGU1 : O_WGU2), NTOK, 2 * DFF, D, D, 30, 0}; pg8::StaticOrder S; S.init(NTOK, 2 * DFF, D, F.G, F.bid);
                pg8::EpiSwiglu E{PB};
                pg8::gemm_phase<pg8::EpiSwiglu, pg8::StaticOrder>(F.lds, g, S, E, F.tid);
            } else if ((PHM & 16) && (sp == 2 || sp == 13)) {
                const Ctx F = relaunder(F0);
                pg8::Gemm g{PB, WL + (sp == 2 ? O_WD1 : O_WD2), NTOK, D, DFF, DFF, 30, 0}; pg8::ResidOrder S; S.init(DFF, 11, F.G, F.bid);
                pg8::EpiResid E{X, modl, sp == 2 ? 2 : 8, rep == 0 ? 0.5f : 0.0f, DFF / 64, (float*)(ws + WS_PART), 2};
                pg8::gemm_phase<pg8::EpiResid, pg8::ResidOrder>(F.lds, g, S, E, F.tid);
            } else if ((PHM & 32) && sp == 4) {
                const Ctx F = relaunder(F0);
                pg8::Gemm g{XN, WL + O_WIN, NTOK, INW, D, D, 30, 0}; pg8::StaticOrder S; S.init(NTOK, INW, D, F.G, F.bid);
                pg8::EpiPlain E{PB, INW};
                pg8::gemm_phase<pg8::EpiPlain, pg8::StaticOrder>(F.lds, g, S, E, F.tid);
            } else if ((PHM & 64) && sp == 5) { { const Ctx F = relaunder(F0); prep_h1_phase(F.lds, ws, in_ptr(14), l, F.tid, F.bid, F.G); } { const Ctx F = relaunder(F0); prep_pool_phase(F, args, l); } { const Ctx F = relaunder(F0); prep_qkv_phase(F, args, l, rep); } }
            else if ((PHM & 128) && sp == 6) { const Ctx F = relaunder(F0); small_attn_phase(F, args, l, rep); }
            else if ((PHM & 128) && sp == 7) {
                { const Ctx F = relaunder(F0); attn_phase(F, args, l); }
                __syncthreads();
                if (PHM & 256) { const Ctx F = relaunder(F0); hgrn_out_phase(F, args, l); }
            }
            else if ((PHM & 512) && sp == 8) {
                const Ctx F = relaunder(F0);
                pg8::Gemm g{Y, WL + O_WB, NTOK, 4096, 256, D, 2, 512}; pg8::ZOrder S; S.init(F.G, F.bid);
                pg8::EpiGateAcc E{PB + C_GATE, INW, XN, (float*)(ws + WS_PART)};
                pg8::gemm_phase<pg8::EpiGateAcc, pg8::ZOrder>(F.lds, g, S, E, F.tid);
            } else if ((PHM & 1024) && sp == 9) { const Ctx F = relaunder(F0); ctxsum_phase(F, (const float*)(ws + WS_PART), XN); }
            else if ((PHM & 1024) && sp == 10) {
                const Ctx F = relaunder(F0);
                pg8::Gemm g{XN, WL + O_WO4, NTOK, D, D, D, 30, 0}; pg8::ResidOrder S; S.init(D, 8, F.G, F.bid);
                pg8::EpiResid E{X, modl, 5, rep == 0 ? 1.0f : 0.0f, D / 64, (float*)(ws + WS_PART), 1};
                pg8::gemm_phase<pg8::EpiResid, pg8::ResidOrder>(F.lds, g, S, E, F.tid);
            }
        }
        }
        if (ph + 1 < args.ph_hi) { if (ph == 0) grid.sync(); else xcd_barrier(xbar); if (PROBE_DBL & 128) xcd_barrier(xbar); }
    }
}

extern "C" void kernel_launch(void* const* d_in, const int* in_sizes, int n_in, void* d_out, int out_size, void* d_ws, size_t ws_size, hipStream_t stream) {
    static int grid = 0;
    if (grid == 0) {
        if (n_in != 26 || in_sizes[0] != SEQ * D || out_size != SEQ * D || ws_size < WS_END) {
            fprintf(stderr, "kernel_launch: unexpected shapes (n_in %d, in0 %d, out %d, ws %zu, need %zu); nothing launched\n", n_in, n_in > 0 ? in_sizes[0] : -1, out_size, ws_size, (size_t)WS_END); grid = -1; return; }
        int dev = 0, cus = 0, per_cu = 0;
        hipGetDevice(&dev); hipDeviceGetAttribute(&cus, hipDeviceAttributeMultiprocessorCount, dev);
        if (hipFuncSetAttribute((const void*)mk_fwd, hipFuncAttributeMaxDynamicSharedMemorySize, LDS_BYTES) != hipSuccess) { fprintf(stderr, "kernel_launch: hipFuncSetAttribute failed\n"); grid = -1; return; }
        if (hipOccupancyMaxActiveBlocksPerMultiprocessor(&per_cu, (const void*)mk_fwd, 512, LDS_BYTES) != hipSuccess || per_cu < 1) { fprintf(stderr, "kernel_launch: occupancy query says %d blocks per CU\n", per_cu); per_cu = 1; }
        (void)hipGetLastError();
        grid = cus * (per_cu > 1 ? 1 : per_cu);
        if (grid <= 0) grid = 256;
    }
    if (grid < 0) return;
    if (hipMemsetAsync(d_ws, 0, 16384, stream) != hipSuccess) { fprintf(stderr, "kernel_launch: hipMemsetAsync failed\n"); return; }
    Args a{};
    for (int i = 0; i < 26; ++i) a.in[i] = (const float*)d_in[i];
    a.out = (float*)d_out; a.ws = (unsigned char*)d_ws;
#if MK_PER_PHASE
    for (int ph = 0; ph < NPHASE; ++ph) { a.ph_lo = ph; a.ph_hi = ph + 1; hipLaunchKernelGGL(mk_fwd, dim3(grid), dim3(512), LDS_BYTES, stream, a); }
#else
    a.ph_lo = 0; a.ph_hi = NPHASE;
    void* kargs[] = {&a};
    hipError_t e = hipLaunchCooperativeKernel((const void*)mk_fwd, dim3(grid), dim3(512), kargs, LDS_BYTES, stream);
    if (e != hipSuccess) fprintf(stderr, "kernel_launch: cooperative launch failed: %s (grid %d)\n", hipGetErrorString(e), grid);
#endif
}
```

```cpp
#include <hip/hip_runtime.h>
#include <hip/hip_cooperative_groups.h>
#include <cstdio>
#include <cstdint>
namespace cg = cooperative_groups;

#ifndef MK_PER_PHASE
#define MK_PER_PHASE 0
#endif

#ifndef PROBE_DBL
#define PROBE_DBL 0
#endif
#ifndef PHM
#define PHM 0xffff
#endif
#define LAS __attribute__((address_space(3)))
typedef unsigned short bf16_t;
typedef short bf16x8 __attribute__((ext_vector_type(8)));
typedef short s16x4 __attribute__((ext_vector_type(4)));
typedef float f32x4 __attribute__((ext_vector_type(4)));
typedef float f32x16 __attribute__((ext_vector_type(16)));
typedef unsigned u32x4 __attribute__((ext_vector_type(4)));
typedef unsigned u32x2 __attribute__((ext_vector_type(2)));

constexpr int D = 1024, SEQ = 16384, CTX = 256, NTOK = SEQ + CTX, DEPTH = 4, DFF = 2816, INW = 6912, NMODV = 9 * 1024;
constexpr int C_AQ = 0, C_AK = 256, C_AV = 384, C_BQ = 512, C_BFF = 768, C_BFB = 1024, C_BI = 1280, C_BG = 1536, C_CX = 1792, C_DQ = 2048, C_DK = 2304, C_DV = 2560, C_GATE = 2816;
constexpr int NCHUNK = NTOK / 64;
constexpr float EPSN = 1e-6f;
constexpr float LOG2E = 1.4426950408889634f;
constexpr float ATT_SCALE = 0.125f;

constexpr size_t O_WGU1 = 0, O_WD1 = O_WGU1 + (size_t)2 * DFF * D, O_WIN = O_WD1 + (size_t)D * DFF, O_WB = O_WIN + (size_t)INW * D, O_WO4 = O_WB + (size_t)4096 * 256,
                 O_WGU2 = O_WO4 + (size_t)1024 * 1024, O_WD2 = O_WGU2 + (size_t)2 * DFF * D, LAYER_W = O_WD2 + (size_t)D * DFF;
constexpr size_t WS_W = 1u << 20;
constexpr size_t WS_MOD = WS_W + LAYER_W * 2 * DEPTH;
constexpr size_t WS_X = WS_MOD + (size_t)DEPTH * 2 * NMODV * 4 + 1024;
constexpr size_t WS_XN = WS_X + (size_t)NTOK * D * 4;
constexpr size_t WS_HA = WS_XN + (size_t)NTOK * D * 2;
constexpr size_t WS_PB = WS_HA + (size_t)2 * NCHUNK * 4 * 64 * 4;
constexpr size_t WS_Y = WS_PB + (size_t)NTOK * INW * 2;
constexpr size_t WS_VTA = WS_Y + (size_t)NTOK * D * 2;
constexpr size_t WS_VTD = WS_VTA + (size_t)2 * 64 * NTOK * 2;
constexpr size_t WS_PART = WS_VTD + (size_t)4 * 64 * NTOK * 2;
constexpr size_t WS_END = WS_PART + (size_t)11 * 256 * 1024 * 4;
static_assert(WS_X % 256 == 0 && WS_XN % 256 == 0 && WS_PB % 256 == 0 && WS_Y % 256 == 0 && WS_VTA % 256 == 0, "ws align");
static_assert((size_t)2 * NCHUNK * 4 * 4096 * 4 <= (size_t)NTOK * D * 2, "GS overlay fits XN");

constexpr int LDS_BYTES = 148480;
constexpr int NSUB = 14;
constexpr int NPHASE = 1 + NSUB * DEPTH + 1;

__device__ __forceinline__ float bf2f(unsigned v) { return __uint_as_float(v << 16); }
typedef __bf16 bf16x2_t __attribute__((ext_vector_type(2)));
typedef float f32x2_t __attribute__((ext_vector_type(2)));
__device__ __forceinline__ unsigned pk2(float lo, float hi) { const f32x2_t v = {lo, hi}; const bf16x2_t b = __builtin_convertvector(v, bf16x2_t); return __builtin_bit_cast(unsigned, b); }
__device__ __forceinline__ unsigned f2bf(float f) { return pk2(f, 0.f) & 0xffffu; }
__device__ __forceinline__ float lo16(unsigned w) { return __uint_as_float(w << 16); }
__device__ __forceinline__ float hi16(unsigned w) { return __uint_as_float(w & 0xffff0000u); }
__device__ __forceinline__ float max3f(float a, float b, float c) { float r; asm("v_max3_f32 %0, %1, %2, %3" : "=v"(r) : "v"(a), "v"(b), "v"(c)); return r; }
template <int K> __device__ __forceinline__ float swz_xor(float v) { return __uint_as_float((unsigned)__builtin_amdgcn_ds_swizzle((int)__float_as_uint(v), (K << 10) | 0x1f)); }
__device__ __forceinline__ float xor32_sum(float v) { const auto rr = __builtin_amdgcn_permlane32_swap(__float_as_uint(v), __float_as_uint(v), false, false); return __uint_as_float(rr[0]) + __uint_as_float(rr[1]); }
__device__ __forceinline__ float xor32_max(float v) { const auto rr = __builtin_amdgcn_permlane32_swap(__float_as_uint(v), __float_as_uint(v), false, false); return fmaxf(__uint_as_float(rr[0]), __uint_as_float(rr[1])); }
__device__ __forceinline__ float wave_sum(float v) {
    v += swz_xor<1>(v); v += swz_xor<2>(v); v += swz_xor<4>(v); v += swz_xor<8>(v); v += swz_xor<16>(v);
    return xor32_sum(v);
}
__device__ __forceinline__ float sigmoidf_(float x) { return __builtin_amdgcn_rcpf(1.0f + __builtin_amdgcn_exp2f(-1.4426950408889634f * x)); }
__device__ __forceinline__ float siluf_(float x) { return x * __builtin_amdgcn_rcpf(1.0f + __builtin_amdgcn_exp2f(-1.4426950408889634f * x)); }

__device__ __forceinline__ void fadd_agent(float* p, float v) { (void)__hip_atomic_fetch_add(p, v, __ATOMIC_RELAXED, __HIP_MEMORY_SCOPE_AGENT); }

namespace pg8 {
constexpr int BM = 256, BK = 64, HALF = 128, HTB = HALF * BK * 2, STAGE_BYTES = 8 * HTB, NXCD = 8, WGM = 8;
__host__ __device__ __forceinline__ int lds_byte(int r, int c) { const int st = (r >> 4) * 2 + (c >> 5), rr = r & 15, cc = c & 31, ob = rr * 64 + cc * 2; return st * 1024 + (ob ^ (((ob >> 9) & 1) << 5)); }
__host__ __device__ __forceinline__ void stage_rc(int b, int& R, int& C) { const int st = b / 1024, sb = b % 1024, swz = sb ^ (((sb >> 9) & 1) << 5); R = (st >> 1) * 16 + swz / 64; C = (st & 1) * 32 + (swz % 64) / 2; }
__host__ __device__ __forceinline__ int perm32(int rho) { const int n = rho >> 4, i = rho & 15; return 8 * (i >> 2) + 4 * n + (i & 3); }

struct Unit { int pm, pn, kt0, nkt; };
struct Gemm { const bf16_t* A; const bf16_t* Bt; int M, N, K, lda, a_sh, a_str; };

struct StaticOrder {
    int nM, nN, nwg, G, c, nkt;
    __host__ __device__ void init(int M, int N, int K, int G_, int c_) { nM = M / BM; nN = N / BM; nwg = nM * nN; G = G_; c = c_; nkt = K / BK; }
    __host__ __device__ bool next(int i, Unit& u) const {
        const long L = (long)i * G + c; if (L >= nwg) return false;
        int wgid = (int)L; { const int q = nwg / NXCD, r = nwg % NXCD, xcd = wgid % NXCD, off = wgid / NXCD; wgid = (xcd < r ? xcd * (q + 1) : r * (q + 1) + (xcd - r) * q) + off; }
        const int nig = WGM * nN, gid = wgid / nig, fm = gid * WGM, gsz = (nM - fm) < WGM ? (nM - fm) : WGM;
        u.pm = fm + ((wgid % nig) % gsz); u.pn = (wgid % nig) / gsz; u.kt0 = 0; u.nkt = nkt; return true;
    }
};
struct ResidOrder {
    int G, c, nkt, ksplit;
    __host__ __device__ void init(int K, int ksplit_, int G_, int c_) { G = G_; c = c_; nkt = K / BK; ksplit = ksplit_; }
    __host__ __device__ bool next(int i, Unit& u) const {
        const long L = (long)i * G + c;
        const bool lat = L < 256; const int Lc = (int)L - 256;
        int wgid = (int)(L & 255); wgid = (wgid % NXCD) * (256 / NXCD) + wgid / NXCD;
        const int nig = WGM * 4, fm = (wgid / nig) * WGM;
        const int pm_l = fm + ((wgid % nig) % WGM), pn_l = (wgid % nig) / WGM, nk_s = nkt / ksplit;
        u.pm = lat ? pm_l : SEQ / BM; u.pn = lat ? pn_l : (Lc & 3); u.nkt = lat ? nkt : nk_s; u.kt0 = lat ? 0 : (Lc >> 2) * nk_s;
        return lat || (Lc < 4 * ksplit);
    }
};


struct EpiSwiglu {
    static constexpr bool PERM = false;
    bf16_t* H;
    __device__ __forceinline__ void operator()(const f32x4 (&acc)[2][2][4][2], const Unit& u, int wr, int wc, int fr, int fq) const {
        const int row0 = u.pm * BM + wr * 64 + fr;
#pragma unroll
        for (int ai = 0; ai < 2; ++ai)
#pragma unroll
            for (int m = 0; m < 4; ++m) {
                bf16_t* rowp = H + (size_t)(row0 + ai * HALF + m * 16) * DFF;
#pragma unroll
                for (int bj = 0; bj < 2; ++bj) {
                    const int hid = (u.pn * 8 + bj * 4 + wc) * 16 + 4 * fq;
                    const f32x4 g = acc[ai][bj][m][0], up = acc[ai][bj][m][1];
                    u32x2 w; w.x = pk2(siluf_(g[0]) * up[0], siluf_(g[1]) * up[1]); w.y = pk2(siluf_(g[2]) * up[2], siluf_(g[3]) * up[3]);
                    *(u32x2*)(rowp + hid) = w;
                }
            }
    }
};
struct EpiResid {
    static constexpr bool PERM = false;
    float* X; const float* modl; int sel; float coef; int nkt_full; float* part; int ksh;
    __device__ __forceinline__ void operator()(const f32x4 (&acc)[2][2][4][2], const Unit& u, int wr, int wc, int fr, int fq) const {
        const float* mv = modl + (u.pm == (SEQ / BM) ? NMODV : 0) + sel * 1024;
        const int col0 = u.pn * BM + wc * 32 + 4 * fq;
        const bool split = u.nkt != nkt_full;
        float* base = split ? part + ((ptrdiff_t)(u.kt0 >> ksh) * 256 - (ptrdiff_t)u.pm * BM) * D : X;
#pragma unroll
        for (int bj = 0; bj < 2; ++bj)
#pragma unroll
            for (int n = 0; n < 2; ++n) {
                const f32x4 gv = *(const f32x4*)(mv + col0 + bj * HALF + n * 16) * coef;
#pragma unroll
                for (int ai = 0; ai < 2; ++ai)
#pragma unroll
                    for (int m = 0; m < 4; ++m) {
                        float* p = base + (size_t)(u.pm * BM + ai * HALF + wr * 64 + m * 16 + fr) * D + col0 + bj * HALF + n * 16;
                        const f32x4 dv = gv * acc[ai][bj][m][n];
                        if (split) *(f32x4*)p = dv;
                        else { const f32x4 xo = *(const f32x4*)p; *(f32x4*)p = xo + dv; }
                    }
            }
    }
};
struct EpiPlain {
    static constexpr bool PERM = true;
    bf16_t* O; int ldc;
    __device__ __forceinline__ void operator()(const f32x4 (&acc)[2][2][4][2], const Unit& u, int wr, int wc, int fr, int fq) const {
        const int row0 = u.pm * BM + wr * 64 + fr, col0 = u.pn * BM + wc * 32 + 8 * fq;
#pragma unroll
        for (int ai = 0; ai < 2; ++ai)
#pragma unroll
            for (int m = 0; m < 4; ++m) {
                bf16_t* rowp = O + (size_t)(row0 + ai * HALF + m * 16) * ldc + col0;
#pragma unroll
                for (int bj = 0; bj < 2; ++bj) {
                    const f32x4 v0 = acc[ai][bj][m][0], v1 = acc[ai][bj][m][1];
                    if (u.pn >= C_GATE / BM) {
                        const unsigned q0 = (unsigned)(sigmoidf_(v0[0]) * 255.f + 0.5f), q1 = (unsigned)(sigmoidf_(v0[1]) * 255.f + 0.5f), q2 = (unsigned)(sigmoidf_(v0[2]) * 255.f + 0.5f), q3 = (unsigned)(sigmoidf_(v0[3]) * 255.f + 0.5f);
                        const unsigned q4 = (unsigned)(sigmoidf_(v1[0]) * 255.f + 0.5f), q5 = (unsigned)(sigmoidf_(v1[1]) * 255.f + 0.5f), q6 = (unsigned)(sigmoidf_(v1[2]) * 255.f + 0.5f), q7 = (unsigned)(sigmoidf_(v1[3]) * 255.f + 0.5f);
                        u32x2 w8; w8.x = q0 | (q1 << 8) | (q2 << 16) | (q3 << 24); w8.y = q4 | (q5 << 8) | (q6 << 16) | (q7 << 24);
                        unsigned char* gq = (unsigned char*)(O + (size_t)(row0 + ai * HALF + m * 16) * ldc + C_GATE) + (col0 + bj * HALF - C_GATE);
                        *(u32x2*)gq = w8;
                    } else {
                        u32x4 w; w.x = pk2(v0[0], v0[1]); w.y = pk2(v0[2], v0[3]); w.z = pk2(v1[0], v1[1]); w.w = pk2(v1[2], v1[3]);
                        *(u32x4*)(rowp + bj * HALF) = w;
                    }
                }
            }
    }
};
struct EpiGate {
    static constexpr bool PERM = true;
    bf16_t* O; int ldc;
    __device__ __forceinline__ void operator()(const f32x4 (&acc)[2][2][4][2], const Unit& u, int wr, int wc, int fr, int fq) const {
        const int row0 = u.pm * BM + wr * 64 + fr, col0 = u.pn * BM + wc * 32 + 8 * fq;
#pragma unroll
        for (int ai = 0; ai < 2; ++ai)
#pragma unroll
            for (int m = 0; m < 4; ++m) {
                bf16_t* rowp = O + (size_t)(row0 + ai * HALF + m * 16) * ldc + col0;
#pragma unroll
                for (int bj = 0; bj < 2; ++bj) {
                    u32x4 gp = *(const u32x4*)(rowp + bj * HALF);
                    const f32x4 v0 = acc[ai][bj][m][0], v1 = acc[ai][bj][m][1];
                    gp.x = pk2(sigmoidf_(lo16(gp.x)) * v0[0], sigmoidf_(hi16(gp.x)) * v0[1]); gp.y = pk2(sigmoidf_(lo16(gp.y)) * v0[2], sigmoidf_(hi16(gp.y)) * v0[3]);
                    gp.z = pk2(sigmoidf_(lo16(gp.z)) * v1[0], sigmoidf_(hi16(gp.z)) * v1[1]); gp.w = pk2(sigmoidf_(lo16(gp.w)) * v1[2], sigmoidf_(hi16(gp.w)) * v1[3]);
                    *(u32x4*)(rowp + bj * HALF) = gp;
                    asm volatile("" ::: "memory");
                }
            }
    }
};

struct ZOrder {
    int G, c, nch4;
    __host__ __device__ void init(int G_, int c_) { G = G_; c = c_; nch4 = c_ < 256 ? 4 * ((256 - c_ + G_ - 1) / G_) : 0; }
    __host__ __device__ bool next(int i, Unit& u) const {
        const bool lat = i < nch4; const int j = i - nch4, L = j * G + c, T = (i >> 2) * G + c;
        const int b = lat ? (i & 3) : (L >> 2), pnp = lat ? (T & 3) : (L & 3);
        u.pm = lat ? (T >> 2) : SEQ / BM; u.pn = b * 4 + pnp; u.kt0 = 0; u.nkt = 4;
        return lat || (L < 16);
    }
};
struct EpiGateAcc {
    static constexpr bool PERM = true;
    const bf16_t* Gp; int ldg; bf16_t* MG; float* part;
    __device__ __forceinline__ void operator()(const f32x4 (&acc)[2][2][4][2], const Unit& u, int wr, int wc, int fr, int fq) const {
        const int b = u.pn >> 2, pnp = u.pn & 3;
        const int rloc = wr * 64 + fr, colg = u.pn * BM + wc * 32 + 8 * fq, colm = pnp * BM + wc * 32 + 8 * fq;
        const bool ctx = u.pm == SEQ / BM;
#pragma unroll
        for (int ai = 0; ai < 2; ++ai)
#pragma unroll
            for (int m = 0; m < 4; ++m) {
                const int rl = rloc + ai * HALF + m * 16;
                const unsigned char* gp_ = (const unsigned char*)(Gp + (size_t)(u.pm * BM + rl) * ldg) + colg;
#pragma unroll
                for (int bj = 0; bj < 2; ++bj) {
                    const u32x2 gp = *(const u32x2*)(gp_ + bj * HALF);
                    const f32x4 v0 = acc[ai][bj][m][0] * (1.0f / 255.0f), v1 = acc[ai][bj][m][1] * (1.0f / 255.0f);
                    f32x4 z0 = {(float)(gp.x & 255u) * v0[0], (float)((gp.x >> 8) & 255u) * v0[1], (float)((gp.x >> 16) & 255u) * v0[2], (float)(gp.x >> 24) * v0[3]};
                    f32x4 z1 = {(float)(gp.y & 255u) * v1[0], (float)((gp.y >> 8) & 255u) * v1[1], (float)((gp.y >> 16) & 255u) * v1[2], (float)(gp.y >> 24) * v1[3]};
                    if (ctx) {
                        float* pp = part + ((size_t)(b * 256 + rl)) * D + colm + bj * HALF;
                        *(f32x4*)pp = z0; *(f32x4*)(pp + 4) = z1;
                    } else {
                        bf16_t* mp = MG + (size_t)(u.pm * BM + rl) * D + colm + bj * HALF;
                        if (b != 0) { const u32x4 pv = *(const u32x4*)mp;
                            z0 += (f32x4){lo16(pv.x), hi16(pv.x), lo16(pv.y), hi16(pv.y)}; z1 += (f32x4){lo16(pv.z), hi16(pv.z), lo16(pv.w), hi16(pv.w)}; }
                        u32x4 w; w.x = pk2(z0[0], z0[1]); w.y = pk2(z0[2], z0[3]); w.z = pk2(z1[0], z1[1]); w.w = pk2(z1[2], z1[3]);
                        *(u32x4*)mp = w;
                    }
                    asm volatile("" ::: "memory");
                }
            }
    }
};

template <class Epi, class Sched>
__device__ __forceinline__ void gemm_phase(LAS unsigned char* lds, const Gemm g, const Sched& S, const Epi& E, const int tid) {
    const int wid = __builtin_amdgcn_readfirstlane(tid >> 6), lane = tid & 63, wr = wid >> 2, wc = wid & 3, fr = lane & 15, fq = lane >> 4;
    const int K = g.K, lda = g.lda;
    unsigned voffA[2], voffB[2];
#pragma unroll
    for (int i = 0; i < 2; ++i) { int R, C; stage_rc(tid * 16 + i * 8192, R, C); const int Rb = Epi::PERM ? ((R & ~31) + perm32(R & 31)) : R;
        voffA[i] = (unsigned)(R * lda + C) * 2u; voffB[i] = (unsigned)(Rb * K + C) * 2u; }
    const size_t kstep = (size_t)(BK * 2);
    const size_t hstepA = (size_t)HALF * lda * 2, hstepB = (size_t)HALF * K * 2;
    const size_t tstepA = 2 * hstepA, tstepB = 2 * hstepB;
    const unsigned ldsw = (unsigned)wid * 1024u;
    const int aoff = lds_byte(wr * 64 + fr, fq * 8), boff = lds_byte(wc * 32 + fr, fq * 8);
#define PG8_UA(u) ((const char*)g.A + (size_t)(u).pm * tstepA + (size_t)(((u).pn >> g.a_sh) * g.a_str) + (size_t)(u).kt0 * kstep)
#define PG8_UB(u) ((const char*)g.Bt + (size_t)(u).pn * tstepB + (size_t)(u).kt0 * kstep)
#define PG8_SA(b, h) (((b) * 2 + (h)) * HTB)
#define PG8_SB(b, h) ((4 + (b) * 2 + (h)) * HTB)
#define PG8_STAGE(bufoff, gbase, voff) do { _Pragma("unroll") for (int _i = 0; _i < 2; ++_i) \
        __builtin_amdgcn_global_load_lds((const unsigned*)((const char*)(gbase) + (voff)[_i]), (LAS unsigned*)(lds + (bufoff) + ldsw + _i * 8192), 16, 0, 0); } while (0)
#define PG8_LDA(dst, b, h) do { _Pragma("unroll") for (int m = 0; m < 4; ++m) _Pragma("unroll") for (int k = 0; k < 2; ++k) dst[m][k] = *(const LAS bf16x8*)(lds + PG8_SA(b, h) + aoff + m * 2048 + k * 1024); } while (0)
#define PG8_LDB(dst, b, h) do { _Pragma("unroll") for (int n = 0; n < 2; ++n) _Pragma("unroll") for (int k = 0; k < 2; ++k) dst[n][k] = *(const LAS bf16x8*)(lds + PG8_SB(b, h) + boff + n * 2048 + k * 1024); } while (0)
#define PG8_MMA(ai, bj, At, Bt) do { __builtin_amdgcn_s_setprio(1); _Pragma("unroll") for (int m = 0; m < 4; ++m) _Pragma("unroll") for (int n = 0; n < 2; ++n) _Pragma("unroll") for (int k = 0; k < 2; ++k) \
        acc[ai][bj][m][n] = __builtin_amdgcn_mfma_f32_16x16x32_bf16(Bt[n][k], At[m][k], acc[ai][bj][m][n], 0, 0, 0); __builtin_amdgcn_s_setprio(0); } while (0)
#define PG8_WAIT_V(n) asm volatile("s_waitcnt vmcnt(" #n ")" ::: "memory")
#define PG8_WAIT_L(n) asm volatile("s_waitcnt lgkmcnt(" #n ")" ::: "memory")
#define PG8_BAR __builtin_amdgcn_s_barrier()
#define PG8_SCHED __builtin_amdgcn_sched_barrier(0)
    Unit cur, nxt; int ui = 0;
    if (!S.next(0, cur)) return;
    f32x4 acc[2][2][4][2];
#pragma unroll
    for (int a = 0; a < 2; ++a)
#pragma unroll
        for (int b = 0; b < 2; ++b)
#pragma unroll
            for (int m = 0; m < 4; ++m)
#pragma unroll
                for (int n = 0; n < 2; ++n) acc[a][b][m][n] = (f32x4){0.f, 0.f, 0.f, 0.f};
    bf16x8 At[4][2], B0[2][2], B1[2][2];
    const char* cA = PG8_UA(cur); const char* cB = PG8_UB(cur);
    PG8_STAGE(PG8_SB(0, 0), cB, voffB); PG8_STAGE(PG8_SB(0, 1), cB + hstepB, voffB); PG8_STAGE(PG8_SA(0, 0), cA, voffA); PG8_STAGE(PG8_SA(0, 1), cA + hstepA, voffA);
    if (wr == 1) PG8_BAR;
    PG8_WAIT_V(2); PG8_BAR;
    PG8_STAGE(PG8_SB(1, 0), cB + kstep, voffB); PG8_STAGE(PG8_SA(1, 0), cA + kstep, voffA); PG8_STAGE(PG8_SB(1, 1), cB + hstepB + kstep, voffB);
    PG8_WAIT_V(6); PG8_BAR;
    for (;;) {
        const bool has_next = S.next(ui + 1, nxt);
        const char* nA = has_next ? PG8_UA(nxt) : cA; const char* nB = has_next ? PG8_UB(nxt) : cB;
        const int nt = cur.nkt;
#pragma unroll 1
        for (int t = 0; t < nt; t += 2) {
            const bool last = (t == nt - 2);
            const char* a1 = cA + (size_t)(t + 1) * kstep;
            const char* a2 = last ? nA : cA + (size_t)(t + 2) * kstep; const char* b2 = last ? nB : cB + (size_t)(t + 2) * kstep;
            const char* a3 = a2 + kstep; const char* b3 = b2 + kstep;
            PG8_LDB(B0, 0, 0); PG8_LDB(B1, 0, 1); PG8_SCHED; PG8_LDA(At, 0, 0); PG8_STAGE(PG8_SA(1, 1), a1 + hstepA, voffA);
            PG8_WAIT_V(8); PG8_WAIT_L(0); PG8_BAR; PG8_MMA(0, 0, At, B0); PG8_MMA(0, 1, At, B1); PG8_BAR; PG8_SCHED;
            PG8_LDA(At, 0, 1); PG8_STAGE(PG8_SB(0, 0), b2, voffB); PG8_STAGE(PG8_SB(0, 1), b2 + hstepB, voffB); PG8_STAGE(PG8_SA(0, 0), a2, voffA);
            PG8_WAIT_V(8); PG8_WAIT_L(0); PG8_BAR; PG8_MMA(1, 0, At, B0); PG8_MMA(1, 1, At, B1); PG8_BAR; PG8_SCHED;
            PG8_LDB(B0, 1, 0); PG8_LDB(B1, 1, 1); PG8_SCHED; PG8_LDA(At, 1, 0); PG8_STAGE(PG8_SA(0, 1), a2 + hstepA, voffA);
            PG8_WAIT_V(8); PG8_WAIT_L(0); PG8_BAR; PG8_MMA(0, 0, At, B0); PG8_MMA(0, 1, At, B1); PG8_BAR; PG8_SCHED;
            PG8_LDA(At, 1, 1); PG8_STAGE(PG8_SB(1, 0), b3, voffB); PG8_STAGE(PG8_SB(1, 1), b3 + hstepB, voffB); PG8_STAGE(PG8_SA(1, 0), a3, voffA);
            PG8_WAIT_V(8); PG8_WAIT_L(0); PG8_BAR; PG8_MMA(1, 0, At, B0); PG8_MMA(1, 1, At, B1); PG8_BAR; PG8_SCHED;
        }
        if (wr == 0) PG8_BAR;
        E(acc, cur, wr, wc, fr, fq);
        if (!has_next) break;
#pragma unroll
        for (int a = 0; a < 2; ++a)
#pragma unroll
            for (int b = 0; b < 2; ++b)
#pragma unroll
                for (int m = 0; m < 4; ++m)
#pragma unroll
                    for (int n = 0; n < 2; ++n) acc[a][b][m][n] = (f32x4){0.f, 0.f, 0.f, 0.f};
        cur = nxt; cA = nA; cB = nB; ++ui;
        if (wr == 1) PG8_BAR;
    }
    PG8_WAIT_V(0);
    PG8_BAR;
#undef PG8_UA
#undef PG8_UB
#undef PG8_SA
#undef PG8_SB
#undef PG8_STAGE
#undef PG8_LDA
#undef PG8_LDB
#undef PG8_MMA
#undef PG8_WAIT_V
#undef PG8_WAIT_L
#undef PG8_BAR
#undef PG8_SCHED
}
}

struct Args {
    const float* in[26];
    float* out; unsigned char* ws;
    int ph_lo, ph_hi;
};
__device__ __forceinline__ const float* in_ptr(int i) {
    const __attribute__((address_space(4))) char* ka = (const __attribute__((address_space(4))) char*)__builtin_amdgcn_kernarg_segment_ptr();
    int off = i * 8; asm volatile("" : "+s"(off));
    return *(const float* const __attribute__((address_space(4)))*)(ka + off);
}
struct Ctx {
    LAS unsigned char* lds;
    int tid, lane, wave, G, bid, gw, ngw;
};

__device__ __forceinline__ void transpose_item(const float* __restrict__ W, int K, int N, bf16_t* __restrict__ WT, int ldw, int koff, int row_off, int mode, LAS float* scr, int item, int lane) {
    const int nblk = N / 32, kb = item / nblk, nb = item % nblk, k0 = 64 * kb, n0 = 32 * nb;
#pragma unroll
    for (int i = 0; i < 32; ++i) { const int kk = 2 * i + (lane >> 5); scr[kk * 33 + (lane & 31)] = W[(size_t)(k0 + kk) * N + n0 + (lane & 31)]; }
    asm volatile("s_waitcnt lgkmcnt(0)" ::: "memory");
    const int c = lane & 7;
#pragma unroll
    for (int j = 0; j < 4; ++j) { const int n = (lane >> 3) + 8 * j; const LAS float* s = scr + (8 * c) * 33 + n;
        u32x4 o; o.x = pk2(s[0 * 33], s[1 * 33]); o.y = pk2(s[2 * 33], s[3 * 33]); o.z = pk2(s[4 * 33], s[5 * 33]); o.w = pk2(s[6 * 33], s[7 * 33]);
        const int ng = n0 + n;
        const int dr = mode == 0 ? ng : (((ng >> 4) << 5) + (ng & 15) + (mode == 2 ? 16 : 0));
        *(u32x4*)(WT + (size_t)(row_off + dr) * ldw + koff + k0 + 8 * c) = o; }
    asm volatile("s_waitcnt lgkmcnt(0)" ::: "memory");
}

__device__ __forceinline__ void phase0(const Ctx& F, const Args& a) {
    unsigned char* ws = a.ws;
    {
        LAS float* sc = (LAS float*)F.lds;
        const float* cvec = in_ptr(1); const float* cctx = in_ptr(3); const float* w_ada = in_ptr(4); const float* b_ada = in_ptr(5);
        float* MOD = (float*)(ws + WS_MOD);
        for (int k = F.tid; k < 2048; k += 512) { const float c = (k < 1024) ? cvec[k] : cctx[k - 1024]; sc[k] = siluf_(c); }
        __syncthreads();
        LAS float* red = sc + 2048;
        for (int it = F.bid; it < DEPTH * 144; it += F.G) {
            const int l = it / 144, n = (it % 144) * 64 + F.lane, k0 = F.wave * 128;
            const float* w = w_ada + (size_t)l * D * NMODV + (size_t)k0 * NMODV + n; float a0 = 0.f, a1 = 0.f;
#pragma unroll 16
            for (int k = 0; k < 128; ++k) { const float wv = w[(size_t)k * NMODV]; a0 += sc[k0 + k] * wv; a1 += sc[1024 + k0 + k] * wv; }
            red[(F.wave * 2 + 0) * 64 + F.lane] = a0; red[(F.wave * 2 + 1) * 64 + F.lane] = a1;
            __syncthreads();
            if (F.wave < 2) { float s = b_ada[l * NMODV + n];
#pragma unroll
                for (int ww = 0; ww < 8; ++ww) s += red[(ww * 2 + F.wave) * 64 + F.lane];
                MOD[(size_t)(l * 2 + F.wave) * NMODV + n] = s; }
            __syncthreads();
        }
    }
    {
        LAS float* scr = (LAS float*)(F.lds + F.wave * 16384);
        constexpr int I_FF = 16 * 88, I_DN = 44 * 32, I_IN = 16 * 216, I_B = 4 * 32, I_O = 16 * 32;
        constexpr int PER_LAYER = 4 * I_FF + 2 * I_DN + I_IN + 4 * I_B + I_O;
        for (int it = F.gw; it < PER_LAYER * DEPTH; it += F.ngw) {
            const int l = it / PER_LAYER; int r = it % PER_LAYER;
            bf16_t* WL = (bf16_t*)(ws + WS_W) + (size_t)l * LAYER_W;
            if (r < I_FF) { transpose_item(in_ptr(7) + (size_t)l * D * DFF, D, DFF, WL + O_WGU1, D, 0, 0, 1, scr, r, F.lane); continue; } r -= I_FF;
            if (r < I_FF) { transpose_item(in_ptr(8) + (size_t)l * D * DFF, D, DFF, WL + O_WGU1, D, 0, 0, 2, scr, r, F.lane); continue; } r -= I_FF;
            if (r < I_DN) { transpose_item(in_ptr(9) + (size_t)l * DFF * D, DFF, D, WL + O_WD1, DFF, 0, 0, 0, scr, r, F.lane); continue; } r -= I_DN;
            if (r < I_IN) { transpose_item(in_ptr(11) + (size_t)l * D * INW, D, INW, WL + O_WIN, D, 0, 0, 0, scr, r, F.lane); continue; } r -= I_IN;
            if (r < 4 * I_B) { const int b = r / I_B; transpose_item(in_ptr(19) + ((size_t)l * 4 + b) * 256 * D, 256, D, WL + O_WB, 256, 0, b * 1024, 0, scr, r % I_B, F.lane); continue; } r -= 4 * I_B;
            if (r < I_O) { transpose_item(in_ptr(20) + (size_t)l * D * D, D, D, WL + O_WO4, D, 0, 0, 0, scr, r, F.lane); continue; } r -= I_O;
            if (r < I_FF) { transpose_item(in_ptr(22) + (size_t)l * D * DFF, D, DFF, WL + O_WGU2, D, 0, 0, 1, scr, r, F.lane); continue; } r -= I_FF;
            if (r < I_FF) { transpose_item(in_ptr(23) + (size_t)l * D * DFF, D, DFF, WL + O_WGU2, D, 0, 0, 2, scr, r, F.lane); continue; } r -= I_FF;
            transpose_item(in_ptr(24) + (size_t)l * DFF * D, DFF, D, WL + O_WD2, DFF, 0, 0, 0, scr, r, F.lane);
        }
    }
    {
        f32x4* X4 = (f32x4*)(ws + WS_X); const f32x4* x4 = (const f32x4*)in_ptr(0); const f32x4* c4 = (const f32x4*)in_ptr(2);
        const size_t n1 = (size_t)SEQ * D / 4, n2 = (size_t)CTX * D / 4;
        for (size_t i = (size_t)F.bid * 512 + F.tid; i < n1 + n2; i += (size_t)F.G * 512) X4[i] = i < n1 ? x4[i] : c4[i - n1];
    }
}

__device__ __forceinline__ void norm_phase(const Ctx& F, float* X, const float* gw, const float* modl, int ish, int isc, bf16_t* XN, const float* part, int nsplit) {
    for (int row = SEQ + F.gw; row < NTOK; row += F.ngw) {
        const float* mv = modl + NMODV;
        f32x4* xr = (f32x4*)(X + (size_t)row * D) + F.lane;
        f32x4 v[4];
#pragma unroll
        for (int j = 0; j < 4; ++j) v[j] = xr[64 * j];
        const f32x4* pr = (const f32x4*)(part + (size_t)(row - SEQ) * D) + F.lane;
        int s = 0;
        for (; s + 4 <= nsplit; s += 4) {
            f32x4 t[4][4];
#pragma unroll
            for (int u = 0; u < 4; ++u)
#pragma unroll
                for (int j = 0; j < 4; ++j) t[u][j] = pr[(size_t)(s + u) * (256 * D / 4) + 64 * j];
#pragma unroll
            for (int u = 0; u < 4; ++u)
#pragma unroll
                for (int j = 0; j < 4; ++j) v[j] += t[u][j];
        }
        for (; s < nsplit; ++s)
#pragma unroll
            for (int j = 0; j < 4; ++j) v[j] += pr[(size_t)s * (256 * D / 4) + 64 * j];
        if (nsplit > 0) {
#pragma unroll
            for (int j = 0; j < 4; ++j) xr[64 * j] = v[j];
        }
        float ss = 0.f;
#pragma unroll
        for (int j = 0; j < 4; ++j) ss += (v[j].x * v[j].x + v[j].y * v[j].y) + (v[j].z * v[j].z + v[j].w * v[j].w);
        const float rs = __builtin_amdgcn_rsqf(wave_sum(ss) * (1.f / D) + EPSN);
#pragma unroll
        for (int j = 0; j < 4; ++j) {
            const int col = 4 * F.lane + 256 * j;
            const f32x4 g4 = *(const f32x4*)(gw + col), sh = *(const f32x4*)(mv + ish * 1024 + col), sc = *(const f32x4*)(mv + isc * 1024 + col);
            const f32x4 o = (v[j] * rs) * (g4 * (sc + 1.0f)) + sh;
            u32x2 w; w.x = pk2(o.x, o.y); w.y = pk2(o.z, o.w);
            *(u32x2*)(XN + (size_t)row * D + col) = w;
        }
    }
    for (int row0 = 4 * F.gw; row0 < SEQ; row0 += 4 * F.ngw) {
        const float* mv = modl;
        f32x4 v[4][4];
#pragma unroll
        for (int r = 0; r < 4; ++r) { const f32x4* xr = (const f32x4*)(X + (size_t)(row0 + r) * D) + F.lane;
#pragma unroll
            for (int j = 0; j < 4; ++j) v[r][j] = xr[64 * j]; }
        float rs[4];
#pragma unroll
        for (int r = 0; r < 4; ++r) { float ss = 0.f;
#pragma unroll
            for (int j = 0; j < 4; ++j) ss += (v[r][j].x * v[r][j].x + v[r][j].y * v[r][j].y) + (v[r][j].z * v[r][j].z + v[r][j].w * v[r][j].w);
            rs[r] = __builtin_amdgcn_rsqf(wave_sum(ss) * (1.f / D) + EPSN); }
#pragma unroll
        for (int j = 0; j < 4; ++j) {
            const int col = 4 * F.lane + 256 * j;
            const f32x4 g4 = *(const f32x4*)(gw + col), sh = *(const f32x4*)(mv + ish * 1024 + col), sc = *(const f32x4*)(mv + isc * 1024 + col);
            const f32x4 gs = g4 * (sc + 1.0f);
#pragma unroll
            for (int r = 0; r < 4; ++r) {
                const f32x4 o = (v[r][j] * rs[r]) * gs + sh;
                u32x2 w; w.x = pk2(o.x, o.y); w.y = pk2(o.z, o.w);
                *(u32x2*)(XN + (size_t)(row0 + r) * D + col) = w;
            }
        }
    }
}
__device__ __forceinline__ void final_norm_phase(const Ctx& F, const float* X, const float* gw, float* out) {
    for (int row = F.gw; row < SEQ; row += F.ngw) {
        const f32x4* xr = (const f32x4*)(X + (size_t)row * D) + F.lane;
        f32x4 v[4]; float ss = 0.f;
#pragma unroll
        for (int j = 0; j < 4; ++j) { v[j] = xr[64 * j]; ss += (v[j].x * v[j].x + v[j].y * v[j].y) + (v[j].z * v[j].z + v[j].w * v[j].w); }
        const float rs = 1.0f / sqrtf(wave_sum(ss) * (1.f / D) + EPSN);
#pragma unroll
        for (int j = 0; j < 4; ++j) { const int col = 4 * F.lane + 256 * j; *(f32x4*)(out + (size_t)row * D + col) = v[j] * rs * *(const f32x4*)(gw + col); }
    }
}

__device__ __forceinline__ void prep_qk(bf16_t* PB, int tok0, int col, const float* gain, bool rope, float outscale, int lane) {
    const int i = lane & 15, tq = lane >> 4;
    const float g0 = gain[i], g1 = gain[16 + i], g2 = gain[32 + i], g3 = gain[48 + i];
    const float inv = exp2f(-(float)i * 0.83048202372184059f);
#pragma unroll 4
    for (int pass = 0; pass < 16; ++pass) {
        const int tok = tok0 + pass * 4 + tq;
        bf16_t* p = PB + (size_t)tok * INW + col + i;
        float x0 = bf2f(p[0]), x1 = bf2f(p[16]), x2 = bf2f(p[32]), x3 = bf2f(p[48]);
        float ss = (x0 * x0 + x1 * x1) + (x2 * x2 + x3 * x3);
        ss += swz_xor<1>(ss); ss += swz_xor<2>(ss); ss += swz_xor<4>(ss); ss += swz_xor<8>(ss);
        const float r = 1.0f / sqrtf(ss * (1.f / 64.f) + EPSN);
        x0 = x0 * r * g0; x1 = x1 * r * g1; x2 = x2 * r * g2; x3 = x3 * r * g3;
        if (rope) {
            const float ar = (float)(tok >> 6) * inv, ac = (float)(tok & 63) * inv;
            const float sr = __sinf(ar), cr = __cosf(ar), sc = __sinf(ac), cc = __cosf(ac);
            const float a0 = x0, b0 = x1; x0 = a0 * cr - b0 * sr; x1 = b0 * cr + a0 * sr;
            const float a1 = x2, b1 = x3; x2 = a1 * cc - b1 * sc; x3 = b1 * cc + a1 * sc;
        }
        p[0] = (bf16_t)f2bf(x0 * outscale); p[16] = (bf16_t)f2bf(x1 * outscale); p[32] = (bf16_t)f2bf(x2 * outscale); p[48] = (bf16_t)f2bf(x3 * outscale);
    }
}
__device__ __forceinline__ void prep_vt(const bf16_t* PB, int tok0, int col, bf16_t* VT, LAS unsigned char* scr, int lane) {
    const bf16_t* p = PB + (size_t)(tok0 + lane) * INW + col;
    LAS unsigned* s32 = (LAS unsigned*)scr;
#pragma unroll
    for (int c = 0; c < 8; ++c) { const u32x4 w = *(const u32x4*)(p + 8 * c);
        s32[lane * 33 + 4 * c + 0] = w.x; s32[lane * 33 + 4 * c + 1] = w.y; s32[lane * 33 + 4 * c + 2] = w.z; s32[lane * 33 + 4 * c + 3] = w.w; }
    asm volatile("s_waitcnt lgkmcnt(0)" ::: "memory");
    const LAS bf16_t* s16 = (const LAS bf16_t*)scr;
    bf16_t* o = VT + (size_t)lane * NTOK + tok0;
#pragma unroll
    for (int c = 0; c < 8; ++c) { u32x4 w; unsigned t[8];
#pragma unroll
        for (int e = 0; e < 8; ++e) t[e] = s16[(8 * c + e) * 66 + lane];
        w.x = t[0] | (t[1] << 16); w.y = t[2] | (t[3] << 16); w.z = t[4] | (t[5] << 16); w.w = t[6] | (t[7] << 16);
        *(u32x4*)(o + 8 * c) = w; }
    asm volatile("s_waitcnt lgkmcnt(0)" ::: "memory");
}
__device__ __forceinline__ float lb_val(const float* logits, int l, int dir, int ch) {
    float v[4]; float mx = -3.0e38f;
#pragma unroll
    for (int j = 0; j < 4; ++j) { v[j] = logits[(j * 2 + dir) * 256 + ch]; mx = fmaxf(mx, v[j]); }
    float s = 0.f, c = 0.f;
#pragma unroll
    for (int j = 0; j < 4; ++j) { v[j] = expf(v[j] - mx); s += v[j]; if (j >= 1 && j <= l) c += v[j]; }
    return c / s;
}
__device__ __forceinline__ int hg_row(int dir, int c, int s) {
    const int p = 64 * c + s;
    if (dir == 0) return p < CTX ? SEQ + p : p - CTX;
    return p < CTX ? SEQ + (CTX - 1) - p : (SEQ - 1) - (p - CTX);
}
__device__ __forceinline__ void hgrn_h1_item(const Ctx& F, const bf16_t* PB, const float* logits, int l, int item, float* GS, float* HA, LAS unsigned char* scrb) {
    const int head = item & 3, c = (item >> 2) % NCHUNK, dir = item / (4 * NCHUNK), lane = F.lane, q_ = lane & 31, h = lane >> 5;
    constexpr int TP = 144;
    LAS unsigned char* TKh = scrb;
    const int colf = (dir ? C_BFB : C_BFF) + head * 64 + lane;
    const float lb = lb_val(logits, l, dir, head * 64 + lane);
    float r = 0.f;
#pragma unroll
    for (int cb = 7; cb >= 0; --cb) {
        float kh[8];
#pragma unroll
        for (int i = 7; i >= 0; --i) {
            const float pre = bf2f(PB[(size_t)hg_row(dir, c, 8 * cb + i) * INW + colf]);
            const float f = lb + (1.0f - lb) * sigmoidf_(pre);
            kh[i] = (1.0f - f) * __expf(r);
            r += __logf(f);
        }
        const u32x4 w = {pk2(kh[0], kh[1]), pk2(kh[2], kh[3]), pk2(kh[4], kh[5]), pk2(kh[6], kh[7])};
        *(LAS u32x4*)(TKh + lane * TP + 16 * cb) = w;
    }
    HA[(size_t)((dir * NCHUNK + c) * 4 + head) * 64 + lane] = __expf(r);
    asm volatile("s_waitcnt lgkmcnt(0)" ::: "memory");
    __builtin_amdgcn_wave_barrier();
    f32x16 g[2][2];
#pragma unroll
    for (int r2 = 0; r2 < 16; ++r2) { g[0][0][r2] = 0.f; g[0][1][r2] = 0.f; g[1][0][r2] = 0.f; g[1][1][r2] = 0.f; }
    const bf16_t* vbase = PB + C_BI + head * 64 + q_;
#pragma unroll
    for (int k = 0; k < 4; ++k) {
        const bf16x8 ka0 = *(const LAS bf16x8*)(TKh + q_ * TP + (16 * k + 8 * h) * 2), ka1 = *(const LAS bf16x8*)(TKh + (32 + q_) * TP + (16 * k + 8 * h) * 2);
#pragma unroll
        for (int vb = 0; vb < 2; ++vb) {
            unsigned e[8];
#pragma unroll
            for (int j = 0; j < 8; ++j) e[j] = vbase[(size_t)hg_row(dir, c, 16 * k + 8 * h + j) * INW + 32 * vb];
            const u32x4 w = {e[0] | (e[1] << 16), e[2] | (e[3] << 16), e[4] | (e[5] << 16), e[6] | (e[7] << 16)};
            const bf16x8 vf = __builtin_bit_cast(bf16x8, w);
            g[0][vb] = __builtin_amdgcn_mfma_f32_32x32x16_bf16(ka0, vf, g[0][vb], 0, 0, 0);
            g[1][vb] = __builtin_amdgcn_mfma_f32_32x32x16_bf16(ka1, vf, g[1][vb], 0, 0, 0);
        }
    }
    float* go = GS + ((size_t)((dir * NCHUNK + c) * 4 + head)) * 4096;
#pragma unroll
    for (int db = 0; db < 2; ++db)
#pragma unroll
        for (int vb = 0; vb < 2; ++vb)
#pragma unroll
            for (int r2 = 0; r2 < 16; ++r2) go[(32 * db + 8 * (r2 >> 2) + 4 * h + (r2 & 3)) * 64 + 32 * vb + q_] = g[db][vb][r2];
    asm volatile("s_waitcnt lgkmcnt(0)" ::: "memory");
    __builtin_amdgcn_wave_barrier();
}
__device__ __forceinline__ void pool_item(const Ctx& F, const bf16_t* PB, const float* wg  , const float* cscale  , bf16_t* Y, int item, LAS unsigned char* scrb) {
    const int g = item & 3, tile = item >> 2, lane = F.lane, q_ = lane & 31, h = lane >> 5;
    const int row0 = tile * 64, sb = row0 >= SEQ ? SEQ : 0, T = row0 >= SEQ ? CTX : SEQ, t0 = row0 - sb;
    const int half = 1 << g;
    LAS bf16_t* xs = (LAS bf16_t*)scrb;
    LAS unsigned char* PT = scrb + 10240;
    const bf16_t* xp = PB + (size_t)sb * INW + C_CX + 64 * g + lane;
#pragma clang loop vectorize(disable) interleave(disable) unroll_count(8)
    for (int i = 0; i < 80; ++i) { const int uc = min(max(t0 - 8 + i, 0), T - 1); xs[i * 64 + lane] = xp[(size_t)uc * INW]; }
    asm volatile("s_waitcnt lgkmcnt(0)" ::: "memory");
    float s = 0.f; int cnt = 0;
#pragma unroll
    for (int k = 0; k < 16; ++k) { const int dk = k - 8, u = t0 + dk; const bool ok = (dk >= -half) && (dk < half) && (u >= 0) && (u < T);
        const float xv = bf2f(xs[(8 + dk) * 64 + lane]); s += ok ? xv : 0.f; cnt += ok ? 1 : 0; }
#pragma unroll 4
    for (int tt = 0; tt < 64; ++tt) {
        if (tt > 0) { const int t = t0 + tt;
            if (t - 1 + half < T) { s += bf2f(xs[(tt + 7 + half) * 64 + lane]); ++cnt; }
            if (t - 1 - half >= 0) { s -= bf2f(xs[(tt + 7 - half) * 64 + lane]); --cnt; } }
        const float pooled = s * __builtin_amdgcn_rcpf((float)cnt) - bf2f(xs[(tt + 8) * 64 + lane]);
        *(LAS bf16_t*)(PT + tt * 128 + 2 * lane) = (bf16_t)f2bf(pooled);
    }
    asm volatile("s_waitcnt lgkmcnt(0)" ::: "memory");
    __builtin_amdgcn_wave_barrier();
    f32x16 acc[2][2];
#pragma unroll
    for (int r = 0; r < 16; ++r) { acc[0][0][r] = 0.f; acc[0][1][r] = 0.f; acc[1][0][r] = 0.f; acc[1][1][r] = 0.f; }
    const float* wp = wg + (size_t)g * 4096 + q_;
#pragma unroll
    for (int k = 0; k < 4; ++k) {
        const bf16x8 a0 = *(const LAS bf16x8*)(PT + q_ * 128 + (16 * k + 8 * h) * 2), a1 = *(const LAS bf16x8*)(PT + (32 + q_) * 128 + (16 * k + 8 * h) * 2);
#pragma unroll
        for (int vb = 0; vb < 2; ++vb) {
            float wv[8];
#pragma unroll
            for (int j = 0; j < 8; ++j) wv[j] = wp[(16 * k + 8 * h + j) * 64 + 32 * vb];
            const u32x4 w = {pk2(wv[0], wv[1]), pk2(wv[2], wv[3]), pk2(wv[4], wv[5]), pk2(wv[6], wv[7])};
            const bf16x8 wf = __builtin_bit_cast(bf16x8, w);
            acc[0][vb] = __builtin_amdgcn_mfma_f32_32x32x16_bf16(a0, wf, acc[0][vb], 0, 0, 0);
            acc[1][vb] = __builtin_amdgcn_mfma_f32_32x32x16_bf16(a1, wf, acc[1][vb], 0, 0, 0);
        }
    }
#pragma unroll
    for (int vb = 0; vb < 2; ++vb) {
        const float sc = cscale[64 * g + 32 * vb + q_];
#pragma unroll
        for (int tb = 0; tb < 2; ++tb)
#pragma unroll
            for (int r = 0; r < 16; ++r)
                Y[(size_t)(row0 + 32 * tb + 8 * (r >> 2) + 4 * h + (r & 3)) * D + 512 + 64 * g + 32 * vb + q_] = (bf16_t)f2bf(acc[tb][vb][r] * sc);
    }
    asm volatile("s_waitcnt lgkmcnt(0)" ::: "memory");
    __builtin_amdgcn_wave_barrier();
}

__device__ __forceinline__ void prep_h1_phase(LAS unsigned char* lds, unsigned char* ws, const float* logits, int l, int tid, int bid, int G) {
    Ctx F; F.lds = lds; F.tid = tid; F.lane = tid & 63; F.wave = __builtin_amdgcn_readfirstlane(tid >> 6); F.G = G; F.bid = bid; F.gw = bid * 8 + F.wave; F.ngw = G * 8;
    const bf16_t* PB = (const bf16_t*)(ws + WS_PB); float* GS = (float*)(ws + WS_XN); float* HA = (float*)(ws + WS_HA);
    LAS unsigned char* scr = F.lds + F.wave * 18432;
    for (int it = F.wave * F.G + F.bid; it < 2 * NCHUNK * 4; it += F.ngw) hgrn_h1_item(F, PB, logits, l, it, GS, HA, scr);
}
__device__ __forceinline__ void prep_pool_phase(const Ctx& F, const Args& a, int l) {
    unsigned char* ws = a.ws;
    const bf16_t* PB = (const bf16_t*)(ws + WS_PB); bf16_t* Y = (bf16_t*)(ws + WS_Y);
    LAS unsigned char* scr = F.lds + F.wave * 18432;
    for (int it = (7 - F.wave) * F.G + F.bid; it < NCHUNK * 4; it += F.ngw) pool_item(F, PB, in_ptr(16) + (size_t)l * 4 * 4096, in_ptr(17) + l * 256, Y, it, scr);
}
__device__ __forceinline__ void prep_qkv_phase(const Ctx& F, const Args& a, int l, int rep) {
    unsigned char* ws = a.ws;
    bf16_t* PB = (bf16_t*)(ws + WS_PB);
    bf16_t* VTA = (bf16_t*)(ws + WS_VTA); bf16_t* VTD = (bf16_t*)(ws + WS_VTD);
    LAS unsigned char* scr = F.lds + F.wave * 18432;
    const int nq = 4 * F.G, sl = (F.wave & 3) * F.G + F.bid;
    const int it_first = F.wave < 4 ? sl : 2 * nq + sl, it_step = F.wave < 4 ? nq : nq, it_end = F.wave < 4 ? 2 * nq : NCHUNK * 12;
    for (int it = it_first; it < it_end && it < NCHUNK * 12; it += it_step) {
        const int tile = it / 12, slot = it % 12, tok0 = tile * 64;
        int ln = F.lane; asm volatile("" : "+v"(ln));
        if (slot < 6 && rep > 0) continue;
        if (slot < 4) prep_qk(PB, tok0, C_AQ + 64 * slot, in_ptr(12) + l * 64, tok0 < SEQ, ATT_SCALE * LOG2E, ln);
        else if (slot < 6) prep_qk(PB, tok0, C_AK + 64 * (slot - 4), in_ptr(13) + l * 64, tok0 < SEQ, 1.0f, ln);
        else if (slot < 8) prep_vt(PB, tok0, C_AV + 64 * (slot - 6), VTA + (size_t)(slot - 6) * 64 * NTOK, scr, ln);
        else prep_vt(PB, tok0, C_DV + 64 * (slot - 8), VTD + (size_t)(slot - 8) * 64 * NTOK, scr, ln);
    }
}

template <bool NA>
__device__ __forceinline__ void attn_unit(LAS unsigned char* lds, const bf16_t* __restrict__ PB, const bf16_t* __restrict__ VT, bf16_t* __restrict__ Y,
                                          int q_tok0, int qcol, int kcol, int ycol, int ntiles, int loc_base, float qs,
                                          int na_r, int na_rs_base, int na_qc0, const float* relb, const int tid) {
    const int lane = tid & 63, q = lane & 31, h = lane >> 5;
    constexpr int KB = 9216, VB = 9216, VOFF = 2 * KB, BOFF = VOFF + 2 * VB;
    LAS float* biasL = (LAS float*)(lds + BOFF);
    bf16x8 qb[4];
    { const bf16_t* qp = PB + (size_t)(q_tok0 + q) * INW + qcol + 8 * h;
#pragma unroll
      for (int s = 0; s < 4; ++s) qb[s] = *(const bf16x8*)(qp + 16 * s); }
    __syncthreads();
    if (NA) { for (int i = tid; i < 465; i += 512) biasL[i] = relb[i] * LOG2E; }
    f32x16 o0, o1, negm;
#pragma unroll
    for (int r = 0; r < 16; ++r) { o0[r] = 0.f; o1[r] = 0.f; negm[r] = 0.f; }
    float m = 0.f, l = 0.f;
    const int srow = tid >> 3, sch = tid & 7;
    u32x4 kreg, vreg;
    { const int t0 = SEQ;
      kreg = *(const u32x4*)(PB + (size_t)(t0 + srow) * INW + kcol + 8 * sch); vreg = *(const u32x4*)(VT + (size_t)srow * NTOK + t0 + 8 * sch); }
    *(LAS u32x4*)(lds + srow * 144 + sch * 16) = kreg;
    { LAS unsigned char* vp = lds + VOFF + srow * 144 + (sch >> 1) * 32 + (sch & 1) * 8;
      *(LAS u32x2*)vp = (u32x2){vreg.x, vreg.y}; *(LAS u32x2*)(vp + 16) = (u32x2){vreg.z, vreg.w}; }
    __syncthreads();
    const int na_cs = NA ? min(max(na_qc0 + q - 8, 0), 48) : 0;
    const int na_rs = NA ? min(max(na_r - 4, 0), 248) : 0;
    for (int j = 0; j < ntiles; ++j) {
        const int cur = j & 1;
        if (j + 1 < ntiles) { const int t0 = (j + 1) < 4 ? SEQ + 64 * (j + 1) : loc_base + 64 * (j + 1 - 4);
            kreg = *(const u32x4*)(PB + (size_t)(t0 + srow) * INW + kcol + 8 * sch); vreg = *(const u32x4*)(VT + (size_t)srow * NTOK + t0 + 8 * sch); }
        bool active = true; int kr = 0;
        if (NA && j >= 4) { kr = na_rs_base + (j - 4); active = (kr >= na_rs) && (kr < na_rs + 8); }
        if (active) {
            const LAS unsigned char* kb = lds + cur * KB; const LAS unsigned char* vb = lds + VOFF + cur * VB;
            f32x16 p0, p1;
            if (NA) {
#pragma unroll
                for (int r = 0; r < 16; ++r) { p0[r] = 0.f; p1[r] = 0.f; }
            } else { p0 = negm; p1 = negm; }
            bf16x8 kf[8], vfr[8];
#pragma unroll
            for (int s = 0; s < 4; ++s) {
                kf[2 * s] = *(const LAS bf16x8*)(kb + q * 144 + (16 * s + 8 * h) * 2);
                kf[2 * s + 1] = *(const LAS bf16x8*)(kb + (q + 32) * 144 + (16 * s + 8 * h) * 2);
            }
#pragma unroll
            for (int s = 0; s < 4; ++s) {
                vfr[2 * s] = *(const LAS bf16x8*)(vb + q * 144 + 32 * s + 16 * h);
                vfr[2 * s + 1] = *(const LAS bf16x8*)(vb + (q + 32) * 144 + 32 * s + 16 * h);
            }
            __builtin_amdgcn_sched_barrier(0);
            __builtin_amdgcn_s_setprio(1);
#pragma unroll
            for (int s = 0; s < 4; ++s) {
                p0 = __builtin_amdgcn_mfma_f32_32x32x16_bf16(kf[2 * s], qb[s], p0, 0, 0, 0);
                p1 = __builtin_amdgcn_mfma_f32_32x32x16_bf16(kf[2 * s + 1], qb[s], p1, 0, 0, 0);
            }
            __builtin_amdgcn_s_setprio(0);
            if (NA) {
                if (j >= 4) {
                    const int dr = kr - na_r + 7, qc = na_qc0 + q;
#pragma unroll
                    for (int r = 0; r < 16; ++r) {
                        const int kc = 8 * (r >> 2) + 4 * h + (r & 3);
                        const bool v0 = (kc >= na_cs) && (kc < na_cs + 16), v1 = (kc + 32 >= na_cs) && (kc + 32 < na_cs + 16);
                        const int i0 = v0 ? dr * 31 + (kc - qc + 15) : 0, i1 = v1 ? dr * 31 + (kc + 32 - qc + 15) : 0;
                        const float b0 = biasL[i0], b1 = biasL[i1];
                        p0[r] = v0 ? p0[r] * qs + b0 - m : -INFINITY; p1[r] = v1 ? p1[r] * qs + b1 - m : -INFINITY;
                    }
                } else {
#pragma unroll
                    for (int r = 0; r < 16; ++r) { p0[r] = p0[r] * qs - m; p1[r] = p1[r] * qs - m; }
                }
            }
            float mx = fmaxf(fmaxf(p0[0], p1[0]), p0[1]), mx2 = fmaxf(fmaxf(p1[1], p0[2]), p1[2]);
#pragma unroll
            for (int r = 3; r < 15; r += 3) { mx = fmaxf(fmaxf(mx, p0[r]), p1[r]); mx2 = fmaxf(fmaxf(mx2, p0[r + 1]), p1[r + 1]); mx = fmaxf(fmaxf(mx, p0[r + 2]), p1[r + 2]); }
            mx = fmaxf(fmaxf(mx, mx2), fmaxf(p0[15], p1[15]));
            mx = xor32_max(mx);
            const bool need = (mx > 0.f) || (j == 0);
            if (__builtin_amdgcn_ballot_w64(need) != 0ull) {
                const float delta = need ? mx : 0.f;
                const float alpha = __builtin_amdgcn_exp2f(-delta);
                m += delta; l *= alpha;
#pragma unroll
                for (int r = 0; r < 16; ++r) { o0[r] *= alpha; o1[r] *= alpha; p0[r] -= delta; p1[r] -= delta; negm[r] = -m; }
            }
            float ls = 0.f;
#pragma unroll
            for (int r = 0; r < 16; ++r) { p0[r] = __builtin_amdgcn_exp2f(p0[r]); p1[r] = __builtin_amdgcn_exp2f(p1[r]); ls += p0[r] + p1[r]; }
            l += ls;
            bf16x8 pb[4];
            { u32x4 w;
              w.x = pk2(p0[0], p0[1]); w.y = pk2(p0[2], p0[3]); w.z = pk2(p0[4], p0[5]); w.w = pk2(p0[6], p0[7]); pb[0] = __builtin_bit_cast(bf16x8, w);
              w.x = pk2(p0[8], p0[9]); w.y = pk2(p0[10], p0[11]); w.z = pk2(p0[12], p0[13]); w.w = pk2(p0[14], p0[15]); pb[1] = __builtin_bit_cast(bf16x8, w);
              w.x = pk2(p1[0], p1[1]); w.y = pk2(p1[2], p1[3]); w.z = pk2(p1[4], p1[5]); w.w = pk2(p1[6], p1[7]); pb[2] = __builtin_bit_cast(bf16x8, w);
              w.x = pk2(p1[8], p1[9]); w.y = pk2(p1[10], p1[11]); w.z = pk2(p1[12], p1[13]); w.w = pk2(p1[14], p1[15]); pb[3] = __builtin_bit_cast(bf16x8, w); }
#pragma unroll
            for (int s = 0; s < 4; ++s) {
                const bf16x8 vf0 = vfr[2 * s], vf1 = vfr[2 * s + 1];
                o0 = __builtin_amdgcn_mfma_f32_32x32x16_bf16(vf0, pb[s], o0, 0, 0, 0);
                o1 = __builtin_amdgcn_mfma_f32_32x32x16_bf16(vf1, pb[s], o1, 0, 0, 0);
            }
        }
        if (j + 1 < ntiles) {
            *(LAS u32x4*)(lds + (cur ^ 1) * KB + srow * 144 + sch * 16) = kreg;
            LAS unsigned char* vp = lds + VOFF + (cur ^ 1) * VB + srow * 144 + (sch >> 1) * 32 + (sch & 1) * 8;
            *(LAS u32x2*)vp = (u32x2){vreg.x, vreg.y}; *(LAS u32x2*)(vp + 16) = (u32x2){vreg.z, vreg.w};
        }
        __syncthreads();
    }
    const float lt = xor32_sum(l), inv = 1.0f / lt;
    bf16_t* yp = Y + (size_t)(q_tok0 + q) * D + ycol + 4 * h;
#pragma unroll
    for (int g4 = 0; g4 < 4; ++g4) {
        u32x2 w0, w1;
        w0.x = pk2(o0[4 * g4] * inv, o0[4 * g4 + 1] * inv); w0.y = pk2(o0[4 * g4 + 2] * inv, o0[4 * g4 + 3] * inv);
        w1.x = pk2(o1[4 * g4] * inv, o1[4 * g4 + 1] * inv); w1.y = pk2(o1[4 * g4 + 2] * inv, o1[4 * g4 + 3] * inv);
        *(u32x2*)(yp + 8 * g4) = w0; *(u32x2*)(yp + 32 + 8 * g4) = w1;
    }
}

__device__ __forceinline__ void small_attn_phase(const Ctx& F, const Args& a, int l, int rep) {
    unsigned char* ws = a.ws;
    bf16_t* PB = (bf16_t*)(ws + WS_PB); bf16_t* Y = (bf16_t*)(ws + WS_Y);
    const bf16_t* VTA = (const bf16_t*)(ws + WS_VTA); const bf16_t* VTD = (const bf16_t*)(ws + WS_VTD);
    float* GS = (float*)(ws + WS_XN); const float* HA = (const float*)(ws + WS_HA);
    const int w = F.wave;
    const int nscan = F.G >= 128 ? 64 : 0;
    const int nwork = F.G - nscan;
    for (int it = (nscan ? F.bid - nwork : F.bid); rep == 0 && it >= 0 && it < 64; it += (nscan ? 64 : F.G)) {
        const int dh = it >> 3, dblk = it & 7, d = dblk * 8 + (F.tid >> 6), v = F.tid & 63;
        float S = 0.f;
        for (int c0 = 0; c0 < NCHUNK; c0 += 20) {
            float gq[20], aq[20];
#pragma unroll
            for (int j = 0; j < 20; ++j) { const size_t u = (size_t)((dh >> 2) * NCHUNK + c0 + j) * 4 + (dh & 3); gq[j] = GS[u * 4096 + d * 64 + v]; aq[j] = HA[u * 64 + d]; }
#pragma unroll
            for (int j = 0; j < 20; ++j) { const size_t u = (size_t)((dh >> 2) * NCHUNK + c0 + j) * 4 + (dh & 3); GS[u * 4096 + d * 64 + v] = S; S = aq[j] * S + gq[j]; }
        }
    }
    if (nscan && F.bid >= nwork) return;
    for (int u = F.bid; u < 256 + 8; u += nwork) {
        if (u < 256) {
            const int head = u & 3, rg = u >> 2, r = 4 * rg + (w >> 1);
            const int rs0 = min(max(4 * rg - 4, 0), 248), rs3 = min(max(4 * rg + 3 - 4, 0), 248);
            attn_unit<true>(F.lds, PB, VTD + (size_t)head * 64 * NTOK, Y, 64 * r + 32 * (w & 1), C_DQ + 64 * head, C_DK + 64 * head, 768 + 64 * head, 4 + (rs3 + 8 - rs0), 64 * rs0,
                            ATT_SCALE * LOG2E, r, rs0, 32 * (w & 1), in_ptr(18) + ((size_t)l * 4 + head) * 465, F.tid);
        } else if (u < 260) { const int uu = u - 256, kvh = uu & 1, t128 = uu >> 1, hq = 2 * kvh + (w >> 2);
            attn_unit<false>(F.lds, PB, VTA + (size_t)kvh * 64 * NTOK, Y, SEQ + t128 * 128 + 32 * (w & 3), C_AQ + 64 * hq, C_AK + 64 * kvh, 64 * hq, 4, 0, 1.0f, 0, 0, 0, nullptr, F.tid);
        } else { const int head = u - 260;
            attn_unit<true>(F.lds, PB, VTD + (size_t)head * 64 * NTOK, Y, SEQ + 32 * w, C_DQ + 64 * head, C_DK + 64 * head, 768 + 64 * head, 4, 0, ATT_SCALE * LOG2E, 0, 0, 0, in_ptr(18) + ((size_t)l * 4 + head) * 465, F.tid);
        }
    }
}
__device__ __forceinline__ void attn_phase(const Ctx& F, const Args& a, int l) {
    unsigned char* ws = a.ws;
    bf16_t* PB = (bf16_t*)(ws + WS_PB); bf16_t* Y = (bf16_t*)(ws + WS_Y);
    const bf16_t* VTA = (const bf16_t*)(ws + WS_VTA);
    const int w = F.wave;
    for (int u = F.bid; u < 256; u += F.G) {
        const int kvh = u & 1, t128 = u >> 1, hq = 2 * kvh + (w >> 2);
        attn_unit<false>(F.lds, PB, VTA + (size_t)kvh * 64 * NTOK, Y, t128 * 128 + 32 * (w & 3), C_AQ + 64 * hq, C_AK + 64 * kvh, 64 * hq, 4 + SEQ / 64, 0, 1.0f, 0, 0, 0, nullptr, F.tid);
    }
}

__device__ __forceinline__ void ctxsum_phase(const Ctx& F, const float* part, bf16_t* MG) {
    for (int i = F.bid * 512 + F.tid; i < CTX * 128; i += F.G * 512) {
        const int r = i >> 7, c8 = (i & 127) * 8;
        const float* p = part + (size_t)r * D + c8;
        f32x4 a0 = *(const f32x4*)p, a1 = *(const f32x4*)(p + 4);
#pragma unroll
        for (int b = 1; b < 4; ++b) { a0 += *(const f32x4*)(p + (size_t)b * 256 * D); a1 += *(const f32x4*)(p + (size_t)b * 256 * D + 4); }
        u32x4 w; w.x = pk2(a0[0], a0[1]); w.y = pk2(a0[2], a0[3]); w.z = pk2(a1[0], a1[1]); w.w = pk2(a1[2], a1[3]);
        *(u32x4*)(MG + (size_t)(SEQ + r) * D + c8) = w;
    }
}

__device__ __forceinline__ void sum4_phase(const Ctx& F, const bf16_t* PB, bf16_t* MG) {
    for (int i = F.bid * 512 + F.tid; i < NTOK * 128; i += F.G * 512) {
        const int row = i >> 7, c8 = (i & 127) * 8;
        const bf16_t* zp = PB + (size_t)row * INW + C_GATE + c8;
        const u32x4 a = *(const u32x4*)zp, b = *(const u32x4*)(zp + 1024), c = *(const u32x4*)(zp + 2048), d = *(const u32x4*)(zp + 3072);
        u32x4 o;
        o.x = pk2((lo16(a.x) + lo16(b.x)) + (lo16(c.x) + lo16(d.x)), (hi16(a.x) + hi16(b.x)) + (hi16(c.x) + hi16(d.x)));
        o.y = pk2((lo16(a.y) + lo16(b.y)) + (lo16(c.y) + lo16(d.y)), (hi16(a.y) + hi16(b.y)) + (hi16(c.y) + hi16(d.y)));
        o.z = pk2((lo16(a.z) + lo16(b.z)) + (lo16(c.z) + lo16(d.z)), (hi16(a.z) + hi16(b.z)) + (hi16(c.z) + hi16(d.z)));
        o.w = pk2((lo16(a.w) + lo16(b.w)) + (lo16(c.w) + lo16(d.w)), (hi16(a.w) + hi16(b.w)) + (hi16(c.w) + hi16(d.w)));
        *(u32x4*)(MG + (size_t)row * D + c8) = o;
    }
}

__device__ __forceinline__ void hgrn_out_phase(const Ctx& F, const Args& a, int l) {
    unsigned char* ws = a.ws;
    const bf16_t* PB = (const bf16_t*)(ws + WS_PB); bf16_t* Y = (bf16_t*)(ws + WS_Y);
    const float* GS = (const float*)(ws + WS_XN);
    constexpr int WREG = 18432, TP = 144;
    const int lane = F.lane, dir = F.wave >> 2, wi = F.wave & 3, q_ = lane & 31, h = lane >> 5;
    LAS unsigned char* TQ = F.lds + F.wave * WREG;
    LAS unsigned char* TK = TQ + 9216;
    LAS float* ob = (LAS float*)TQ;
    const LAS float* ob_f = (const LAS float*)(F.lds + wi * WREG);
    const LAS float* ob_b = (const LAS float*)(F.lds + (wi + 4) * WREG);
    const float og = in_ptr(15)[l * 64 + lane];
    for (int it0 = 4 * F.bid; it0 < NCHUNK * 4; it0 += 4 * F.G) {
        const int it = it0 + wi;
        const int head = it & 3, jc = it >> 2;
        const int rb = jc < 256 ? 64 * jc : SEQ + 64 * (jc - 256);
        {
            const int c = dir == 0 ? (jc < 256 ? 4 + jc : jc - 256) : (jc < 256 ? 4 + 255 - jc : 3 - (jc - 256));
            const float lb = lb_val(in_ptr(14), l, dir, head * 64 + lane);
            const int colf = (dir ? C_BFB : C_BFF) + head * 64 + lane, colq = C_BQ + head * 64 + lane;
            float fv[64]; float ref = 0.f;
#pragma unroll
            for (int t = 0; t < 64; ++t) {
                const float pre = bf2f(PB[(size_t)(rb + (dir ? 63 - t : t)) * INW + colf]);
                const float f = lb + (1.0f - lb) * sigmoidf_(pre);
                fv[t] = f;
                if (t < 32) ref += __logf(f);
            }
            unsigned qh[32]; float cum = 0.f, qh_prev = 0.f;
#pragma unroll
            for (int t = 0; t < 64; ++t) {
                const float qv = bf2f(PB[(size_t)(rb + (dir ? 63 - t : t)) * INW + colq]) * 0.125f;
                cum += __logf(fv[t]);
                const float qt = qv * __expf(fminf(cum - ref, 80.f));
                const float kt = (1.0f - fv[t]) * __expf(fminf(ref - cum, 80.f));
                const float qhv = qv * __expf(cum);
                *(LAS bf16_t*)(TQ + t * TP + 2 * lane) = (bf16_t)f2bf(qt);
                *(LAS bf16_t*)(TK + t * TP + 2 * lane) = (bf16_t)f2bf(kt);
                if (t & 1) qh[t >> 1] = pk2(qh_prev, qhv); else qh_prev = qhv;
            }
            asm volatile("s_waitcnt lgkmcnt(0)" ::: "memory");
            __builtin_amdgcn_wave_barrier();
            f32x16 a00, a01, a11;
#pragma unroll
            for (int r = 0; r < 16; ++r) { a00[r] = 0.f; a01[r] = 0.f; a11[r] = 0.f; }
#pragma unroll
            for (int k = 0; k < 4; ++k) {
                const bf16x8 ka0 = *(const LAS bf16x8*)(TK + q_ * TP + (16 * k + 8 * h) * 2), ka1 = *(const LAS bf16x8*)(TK + (32 + q_) * TP + (16 * k + 8 * h) * 2);
                const bf16x8 qb0 = *(const LAS bf16x8*)(TQ + q_ * TP + (16 * k + 8 * h) * 2), qb1 = *(const LAS bf16x8*)(TQ + (32 + q_) * TP + (16 * k + 8 * h) * 2);
                a00 = __builtin_amdgcn_mfma_f32_32x32x16_bf16(ka0, qb0, a00, 0, 0, 0);
                a01 = __builtin_amdgcn_mfma_f32_32x32x16_bf16(ka0, qb1, a01, 0, 0, 0);
                a11 = __builtin_amdgcn_mfma_f32_32x32x16_bf16(ka1, qb1, a11, 0, 0, 0);
            }
#pragma unroll
            for (int r = 0; r < 16; ++r) { const bool ok = (8 * (r >> 2) + 4 * h + (r & 3)) <= q_; a00[r] = ok ? a00[r] : 0.f; a11[r] = ok ? a11[r] : 0.f; }
            bf16x8 p00[2], p01[2], p11[2];
#pragma unroll
            for (int k = 0; k < 2; ++k) { u32x4 w;
                w.x = pk2(a00[8 * k], a00[8 * k + 1]); w.y = pk2(a00[8 * k + 2], a00[8 * k + 3]); w.z = pk2(a00[8 * k + 4], a00[8 * k + 5]); w.w = pk2(a00[8 * k + 6], a00[8 * k + 7]); p00[k] = __builtin_bit_cast(bf16x8, w);
                w.x = pk2(a01[8 * k], a01[8 * k + 1]); w.y = pk2(a01[8 * k + 2], a01[8 * k + 3]); w.z = pk2(a01[8 * k + 4], a01[8 * k + 5]); w.w = pk2(a01[8 * k + 6], a01[8 * k + 7]); p01[k] = __builtin_bit_cast(bf16x8, w);
                w.x = pk2(a11[8 * k], a11[8 * k + 1]); w.y = pk2(a11[8 * k + 2], a11[8 * k + 3]); w.z = pk2(a11[8 * k + 4], a11[8 * k + 5]); w.w = pk2(a11[8 * k + 6], a11[8 * k + 7]); p11[k] = __builtin_bit_cast(bf16x8, w); }
            asm volatile("s_waitcnt lgkmcnt(0)" ::: "memory");
            __builtin_amdgcn_wave_barrier();
#pragma unroll
            for (int t2 = 0; t2 < 32; ++t2) { *(LAS bf16_t*)(TQ + (2 * t2) * TP + 2 * lane) = (bf16_t)(qh[t2] & 0xffffu); *(LAS bf16_t*)(TQ + (2 * t2 + 1) * TP + 2 * lane) = (bf16_t)(qh[t2] >> 16); }
            f32x16 o[2][2];
#pragma unroll
            for (int r = 0; r < 16; ++r) { o[0][0][r] = 0.f; o[0][1][r] = 0.f; o[1][0][r] = 0.f; o[1][1][r] = 0.f; }
            const bf16_t* vbase = PB + C_BI + head * 64 + q_;
#pragma unroll
            for (int cv = 0; cv < 2; ++cv)
#pragma unroll
                for (int sa = 0; sa < 2; ++sa)
#pragma unroll
                    for (int k = 0; k < 2; ++k) {
                        unsigned e[8];
#pragma unroll
                        for (int j = 0; j < 8; ++j) { const int s = 32 * sa + 16 * k + 8 * (j >> 2) + 4 * h + (j & 3); e[j] = vbase[(size_t)(rb + (dir ? 63 - s : s)) * INW + 32 * cv]; }
                        const u32x4 w = {e[0] | (e[1] << 16), e[2] | (e[3] << 16), e[4] | (e[5] << 16), e[6] | (e[7] << 16)};
                        const bf16x8 vf = __builtin_bit_cast(bf16x8, w);
                        if (sa == 0) { o[cv][0] = __builtin_amdgcn_mfma_f32_32x32x16_bf16(vf, p00[k], o[cv][0], 0, 0, 0); o[cv][1] = __builtin_amdgcn_mfma_f32_32x32x16_bf16(vf, p01[k], o[cv][1], 0, 0, 0); }
                        else o[cv][1] = __builtin_amdgcn_mfma_f32_32x32x16_bf16(vf, p11[k], o[cv][1], 0, 0, 0);
                    }
            asm volatile("s_waitcnt lgkmcnt(0)" ::: "memory");
            __builtin_amdgcn_wave_barrier();
            const float* sbase = GS + ((size_t)((dir * NCHUNK + c) * 4 + head)) * 4096 + q_;
#pragma unroll
            for (int cv = 0; cv < 2; ++cv)
#pragma unroll
                for (int k = 0; k < 4; ++k) {
                    float sv[8];
#pragma unroll
                    for (int j = 0; j < 8; ++j) sv[j] = sbase[(16 * k + 8 * h + j) * 64 + 32 * cv];
                    const u32x4 w = {pk2(sv[0], sv[1]), pk2(sv[2], sv[3]), pk2(sv[4], sv[5]), pk2(sv[6], sv[7])};
                    const bf16x8 sf = __builtin_bit_cast(bf16x8, w);
                    const bf16x8 qb0 = *(const LAS bf16x8*)(TQ + q_ * TP + (16 * k + 8 * h) * 2), qb1 = *(const LAS bf16x8*)(TQ + (32 + q_) * TP + (16 * k + 8 * h) * 2);
                    o[cv][0] = __builtin_amdgcn_mfma_f32_32x32x16_bf16(sf, qb0, o[cv][0], 0, 0, 0);
                    o[cv][1] = __builtin_amdgcn_mfma_f32_32x32x16_bf16(sf, qb1, o[cv][1], 0, 0, 0);
                }
            asm volatile("s_waitcnt lgkmcnt(0)" ::: "memory");
            __builtin_amdgcn_wave_barrier();
#pragma unroll
            for (int cv = 0; cv < 2; ++cv)
#pragma unroll
                for (int tb = 0; tb < 2; ++tb) {
                    const int t = 32 * tb + q_, tt = dir ? 63 - t : t;
#pragma unroll
                    for (int g4 = 0; g4 < 4; ++g4)
                        *(LAS f32x4*)(ob + tt * 64 + 32 * cv + 8 * g4 + 4 * h) = (f32x4){o[cv][tb][4 * g4], o[cv][tb][4 * g4 + 1], o[cv][tb][4 * g4 + 2], o[cv][tb][4 * g4 + 3]};
                }
        }
        __syncthreads();
        {
#pragma unroll 4
            for (int k = 0; k < 32; ++k) {
                const int tt = 32 * dir + k;
                const float ot = ob_f[tt * 64 + lane] + ob_b[tt * 64 + lane];
                const float ss = wave_sum(ot * ot);
                const float gg = bf2f(PB[(size_t)(rb + tt) * INW + C_BG + head * 64 + lane]);
                const float y = ot * (1.0f / sqrtf(ss * (1.f / 64.f) + EPSN)) * og * siluf_(gg);
                Y[(size_t)(rb + tt) * D + 256 + head * 64 + lane] = (bf16_t)f2bf(y);
            }
        }
        __syncthreads();
    }
}

#define XB_TMO      128
#define XB_XCNT(j)  (256  + 64 * (j))
#define XB_XSUB(j)  (1280 + 64 * (j))
#define XB_XGEN(j)  (2304 + 64 * (j))
#define XB_TOP      3328
#define XB_TOPGEN   3392
#define XCD_BAR_WORDS 3456
#define XB_SPIN_CAP (1u << 18)

__device__ __forceinline__ unsigned xb_ld(unsigned* p)              { return __hip_atomic_load(p, __ATOMIC_RELAXED, __HIP_MEMORY_SCOPE_AGENT); }
__device__ __forceinline__ unsigned xb_add(unsigned* p, unsigned v) { return __hip_atomic_fetch_add(p, v, __ATOMIC_RELAXED, __HIP_MEMORY_SCOPE_AGENT); }
__device__ __forceinline__ unsigned xb_xcc_id() { return (unsigned)__builtin_amdgcn_s_getreg((3 << 11) | 20) & 0xFu; }
#define XB_SPIN(cond, bar) do { unsigned _sp = 0; while (cond) { __builtin_amdgcn_s_sleep(1); \
    if ((++_sp & 255u) == 0u) { if (xb_ld(&(bar)[XB_TMO])) break; if (_sp > XB_SPIN_CAP) { atomicAdd(&(bar)[XB_TMO], 1u); break; } } } } while (0)

struct XcdBarrier {
    unsigned* bar; unsigned x;
    volatile LAS unsigned* st;
};

__device__ __forceinline__ XcdBarrier xcd_barrier_post(unsigned* bar, volatile LAS unsigned* st) {
    XcdBarrier b; b.bar = bar; b.x = xb_xcc_id(); b.st = st;
    if (threadIdx.x == 0) (void)xb_add(&bar[XB_XCNT(b.x)], 1u);
    return b;
}
__device__ __forceinline__ void xcd_barrier_complete(unsigned* bar, unsigned x, unsigned& nloc, unsigned& nx) {
    const unsigned G = gridDim.x * gridDim.y * gridDim.z;
    unsigned sum, cnt, mine, sp = 0u;
    for (;;) {
        sum = 0u; cnt = 0u; mine = 0u;
#pragma unroll
        for (unsigned j = 0; j < 16; ++j) { const unsigned c = xb_ld(&bar[XB_XCNT(j)]); sum += c; cnt += (c > 0u) ? 1u : 0u; mine = (j == x) ? c : mine; }
        if (sum == G) break;
        __builtin_amdgcn_s_sleep(1);
        if ((++sp & 255u) == 0u) { if (xb_ld(&bar[XB_TMO])) break; if (sp > XB_SPIN_CAP) { atomicAdd(&bar[XB_TMO], 1u); break; } }
    }
    nloc = mine > 0u ? mine : 1u; nx = cnt > 0u ? cnt : 1u;
}

__device__ __forceinline__ void xcd_barrier(const XcdBarrier& b) {
    asm volatile("s_waitcnt vmcnt(0)" ::: "memory");
    __syncthreads();
    if (threadIdx.x == 0) {
        unsigned* bar = b.bar;
        __builtin_amdgcn_s_waitcnt(0);
        unsigned nloc = b.st[0], nx = b.st[1];
        if (nloc == 0u) { xcd_barrier_complete(bar, b.x, nloc, nx); b.st[0] = nloc; b.st[1] = nx; }
        const unsigned old = xb_add(&bar[XB_XSUB(b.x)], 1u);
        const unsigned gen = old / nloc;
        if (old + 1u == (gen + 1u) * nloc) {
            __builtin_amdgcn_fence(__ATOMIC_RELEASE, "agent");
            asm volatile("s_waitcnt vmcnt(0)" ::: "memory");
            const unsigned og = xb_add(&bar[XB_TOP], 1u);
            const unsigned tg = og / nx;
            if (og + 1u == (tg + 1u) * nx) xb_add(&bar[XB_TOPGEN], 1u);
            else XB_SPIN(xb_ld(&bar[XB_TOPGEN]) == tg, bar);
            __builtin_amdgcn_fence(__ATOMIC_ACQUIRE, "agent");
            xb_add(&bar[XB_XGEN(b.x)], 1u);
            asm volatile("s_waitcnt vmcnt(0)" ::: "memory");
        } else {
            XB_SPIN(xb_ld(&bar[XB_XGEN(b.x)]) == gen, bar);
            __builtin_amdgcn_fence(__ATOMIC_ACQUIRE, "agent");
            asm volatile("s_waitcnt vmcnt(0)" ::: "memory");
        }
    }
    __syncthreads();
}

__device__ __forceinline__ Ctx relaunder(Ctx F) {
    int t = F.tid; asm volatile("" : "+v"(t));
    F.tid = t; F.lane = t & 63; F.wave = __builtin_amdgcn_readfirstlane(t >> 6); F.gw = F.bid * 8 + F.wave;
    return F;
}
__global__ void __launch_bounds__(512, 2) mk_fwd(Args args) {
    extern __shared__ __attribute__((aligned(16))) unsigned char lds_raw[];
    cg::grid_group grid = cg::this_grid();
    unsigned char* ws = args.ws;
    float* X = (float*)(ws + WS_X); bf16_t* XN = (bf16_t*)(ws + WS_XN); bf16_t* PB = (bf16_t*)(ws + WS_PB); bf16_t* Y = (bf16_t*)(ws + WS_Y);
    const int wave0 = __builtin_amdgcn_readfirstlane(threadIdx.x >> 6);
    volatile LAS unsigned* bar_st = (volatile LAS unsigned*)((LAS unsigned char*)lds_raw + (LDS_BYTES - 256));
    if (threadIdx.x < 2) bar_st[threadIdx.x] = 0u;
    __syncthreads();
    const XcdBarrier xbar = xcd_barrier_post((unsigned*)args.ws, bar_st);
    for (int ph = args.ph_lo; ph < args.ph_hi; ++ph) {
        unsigned z_; asm volatile("v_mov_b32 %0, 0" : "=v"(z_));
        const int lane_ = (int)__builtin_amdgcn_mbcnt_hi(~0u, __builtin_amdgcn_mbcnt_lo(~0u, z_)); int bid_ = blockIdx.x;
        asm volatile("" : "+s"(bid_));
        const int tid_ = wave0 * 64 + lane_;
        Ctx F0;
        F0.lds = (LAS unsigned char*)lds_raw;
        F0.tid = tid_; F0.lane = F0.tid & 63; F0.wave = wave0;
        F0.G = gridDim.x; F0.bid = bid_; F0.gw = F0.bid * 8 + F0.wave; F0.ngw = F0.G * 8;
        int nrep = 1;
        if (PROBE_DBL) { const int sp_ = (ph - 1) % NSUB;
            if (ph == 0) nrep = (PROBE_DBL & 1) ? 2 : 1;
            else if (ph == NPHASE - 1) nrep = (PROBE_DBL & 64) ? 2 : 1;
            else if (sp_ == 0 || sp_ == 3 || sp_ == 11) nrep = (PROBE_DBL & 2) ? 2 : 1;
            else if (sp_ == 1 || sp_ == 12) nrep = (PROBE_DBL & 4) ? 2 : 1;
            else if (sp_ == 4) nrep = (PROBE_DBL & 8) ? 2 : 1;
            else if (sp_ == 2 || sp_ == 13) nrep = (PROBE_DBL & 1024) ? 2 : 1;
            else if (sp_ == 10) nrep = (PROBE_DBL & 2048) ? 2 : 1;
            else if (sp_ == 5) nrep = (PROBE_DBL & 256) ? 2 : 1;
            else if (sp_ == 6) nrep = (PROBE_DBL & 512) ? 2 : 1;
            else if (sp_ == 7) nrep = (PROBE_DBL & 16) ? 2 : 1;
            }
        for (int rep = 0; rep < nrep; ++rep) {
        if (ph == 0) { if (PHM & 1) { const Ctx F = relaunder(F0); phase0(F, args); } }
        else if (ph == NPHASE - 1) { if (PHM & 2) { const Ctx F = relaunder(F0); final_norm_phase(F, X, in_ptr(25), args.out); } }
        else {
            const int l = (ph - 1) / NSUB, sp = (ph - 1) % NSUB;
            const float* modl = (const float*)(ws + WS_MOD) + (size_t)l * 2 * NMODV;
            const bf16_t* WL = (const bf16_t*)(ws + WS_W) + (size_t)l * LAYER_W;
            if ((PHM & 4) && sp == 0) { const Ctx F = relaunder(F0); norm_phase(F, X, in_ptr(6) + l * D, modl, 0, 1, XN, (const float*)(ws + WS_PART), l > 0 ? 11 : 0); }
            else if ((PHM & 4) && sp == 3) { const Ctx F = relaunder(F0); norm_phase(F, X, in_ptr(10) + l * D, modl, 3, 4, XN, (const float*)(ws + WS_PART), 11); }
            else if ((PHM & 4) && sp == 11) { const Ctx F = relaunder(F0); norm_phase(F, X, in_ptr(21) + l * D, modl, 6, 7, XN, (const float*)(ws + WS_PART), 8); }
            else if ((PHM & 8) && (sp == 1 || sp == 12)) {
                const Ctx F = relaunder(F0);
                pg8::Gemm g{XN, WL + (sp == 1 ? O_WGU1 : O_WGU2), NTOK, 2 * DFF, D, D, 30, 0}; pg8::StaticOrder S; S.init(NTOK, 2 * DFF, D, F.G, F.bid);
                pg8::EpiSwiglu E{PB};
                pg8::gemm_phase<pg8::EpiSwiglu, pg8::StaticOrder>(F.lds, g, S, E, F.tid);
            } else if ((PHM & 16) && (sp == 2 || sp == 13)) {
                const Ctx F = relaunder(F0);
                pg8::Gemm g{PB, WL + (sp == 2 ? O_WD1 : O_WD2), NTOK, D, DFF, DFF, 30, 0}; pg8::ResidOrder S; S.init(DFF, 11, F.G, F.bid);
                pg8::EpiResid E{X, modl, sp == 2 ? 2 : 8, rep == 0 ? 0.5f : 0.0f, DFF / 64, (float*)(ws + WS_PART), 2};
                pg8::gemm_phase<pg8::EpiResid, pg8::ResidOrder>(F.lds, g, S, E, F.tid);
            } else if ((PHM & 32) && sp == 4) {
                const Ctx F = relaunder(F0);
                pg8::Gemm g{XN, WL + O_WIN, NTOK, INW, D, D, 30, 0}; pg8::StaticOrder S; S.init(NTOK, INW, D, F.G, F.bid);
                pg8::EpiPlain E{PB, INW};
                pg8::gemm_phase<pg8::EpiPlain, pg8::StaticOrder>(F.lds, g, S, E, F.tid);
            } else if ((PHM & 64) && sp == 5) { { const Ctx F = relaunder(F0); prep_h1_phase(F.lds, ws, in_ptr(14), l, F.tid, F.bid, F.G); } { const Ctx F = relaunder(F0); prep_pool_phase(F, args, l); } { const Ctx F = relaunder(F0); prep_qkv_phase(F, args, l, rep); } }
            else if ((PHM & 128) && sp == 6) { const Ctx F = relaunder(F0); small_attn_phase(F, args, l, rep); }
            else if ((PHM & 128) && sp == 7) {
                { const Ctx F = relaunder(F0); attn_phase(F, args, l); }
                __syncthreads();
                if (PHM & 256) { const Ctx F = relaunder(F0); hgrn_out_phase(F, args, l); }
            }
            else if ((PHM & 512) && sp == 8) {
                const Ctx F = relaunder(F0);
                pg8::Gemm g{Y, WL + O_WB, NTOK, 4096, 256, D, 2, 512}; pg8::ZOrder S; S.init(F.G, F.bid);
                pg8::EpiGateAcc E{PB + C_GATE, INW, XN, (float*)(ws + WS_PART)};
                pg8::gemm_phase<pg8::EpiGateAcc, pg8::ZOrder>(F.lds, g, S, E, F.tid);
            } else if ((PHM & 1024) && sp == 9) { const Ctx F = relaunder(F0); ctxsum_phase(F, (const float*)(ws + WS_PART), XN); }
            else if ((PHM & 1024) && sp == 10) {
                const Ctx F = relaunder(F0);
                pg8::Gemm g{XN, WL + O_WO4, NTOK, D, D, D, 30, 0}; pg8::ResidOrder S; S.init(D, 8, F.G, F.bid);
                pg8::EpiResid E{X, modl, 5, rep == 0 ? 1.0f : 0.0f, D / 64, (float*)(ws + WS_PART), 1};
                pg8::gemm_phase<pg8::EpiResid, pg8::ResidOrder>(F.lds, g, S, E, F.tid);
            }
        }
        }
        if (ph + 1 < args.ph_hi) { if (ph == 0) grid.sync(); else xcd_barrier(xbar); if (PROBE_DBL & 128) xcd_barrier(xbar); }
    }
}

extern "C" void kernel_launch(void* const* d_in, const int* in_sizes, int n_in, void* d_out, int out_size, void* d_ws, size_t ws_size, hipStream_t stream) {
    static int grid = 0;
    if (grid == 0) {
        if (n_in != 26 || in_sizes[0] != SEQ * D || out_size != SEQ * D || ws_size < WS_END) {
            fprintf(stderr, "kernel_launch: unexpected shapes (n_in %d, in0 %d, out %d, ws %zu, need %zu); nothing launched\n", n_in, n_in > 0 ? in_sizes[0] : -1, out_size, ws_size, (size_t)WS_END); grid = -1; return; }
        int dev = 0, cus = 0, per_cu = 0;
        hipGetDevice(&dev); hipDeviceGetAttribute(&cus, hipDeviceAttributeMultiprocessorCount, dev);
        if (hipFuncSetAttribute((const void*)mk_fwd, hipFuncAttributeMaxDynamicSharedMemorySize, LDS_BYTES) != hipSuccess) { fprintf(stderr, "kernel_launch: hipFuncSetAttribute failed\n"); grid = -1; return; }
        if (hipOccupancyMaxActiveBlocksPerMultiprocessor(&per_cu, (const void*)mk_fwd, 512, LDS_BYTES) != hipSuccess || per_cu < 1) { fprintf(stderr, "kernel_launch: occupancy query says %d blocks per CU\n", per_cu); per_cu = 1; }
        (void)hipGetLastError();
        grid = cus * (per_cu > 1 ? 1 : per_cu);
        if (grid <= 0) grid = 256;
    }
    if (grid < 0) return;
    if (hipMemsetAsync(d_ws, 0, 16384, stream) != hipSuccess) { fprintf(stderr, "kernel_launch: hipMemsetAsync failed\n"); return; }
    Args a{};
    for (int i = 0; i < 26; ++i) a.in[i] = (const float*)d_in[i];
    a.out = (float*)d_out; a.ws = (unsigned char*)d_ws;
#if MK_PER_PHASE
    for (int ph = 0; ph < NPHASE; ++ph) { a.ph_lo = ph; a.ph_hi = ph + 1; hipLaunchKernelGGL(mk_fwd, dim3(grid), dim3(512), LDS_BYTES, stream, a); }
#else
    a.ph_lo = 0; a.ph_hi = NPHASE;
    void* kargs[] = {&a};
    hipError_t e = hipLaunchCooperativeKernel((const void*)mk_fwd, dim3(grid), dim3(512), kargs, LDS_BYTES, stream);
    if (e != hipSuccess) fprintf(stderr, "kernel_launch: cooperative launch failed: %s (grid %d)\n", hipGetErrorString(e), grid);
#endif
}
```
